# Optimizing an MI355X kernel written in HIP

```python
import jax, jax.numpy as jnp
from jax import lax
import numpy as np

D_MODEL = 1024
BATCH = 8
SEQ = 4096
DEPTH = 1

CHUNK = 64
N_LEFT_CHUNKS = 8
BAND = (N_LEFT_CHUNKS + 1) * CHUNK
D_MIX = D_MODEL
D_ATTN = D_MIX // 2
HEAD_DIM = 64
N_HEADS = D_ATTN // HEAD_DIM
D_POOL = D_MIX - D_ATTN
POOL_WINDOWS = (2, 4, 8, 16)
N_POOL_GROUPS = len(POOL_WINDOWS)
POOL_GROUP_DIM = D_POOL // N_POOL_GROUPS
REL_CLIP = 128
N_REL = 2 * REL_CLIP + 1
D_FF = 2816
D_IN = 3 * D_ATTN + D_POOL
EPS = 1e-6
NEG_INF = -1e30

kernel_name = "hybrid_chunk_attn_pool_macaron"


def rmsnorm(x, g):
    xf = x.astype(jnp.float32)
    y = xf * lax.rsqrt(jnp.mean(xf * xf, axis=-1, keepdims=True) + EPS)
    return (y * g.astype(jnp.float32)).astype(x.dtype)


def swiglu_ffn(x, w_gate, w_up, w_down):
    return (jax.nn.silu(x @ w_gate) * (x @ w_up)) @ w_down


def multiscale_pool(u, pool_w, pool_scale):
    B, S, _ = u.shape
    uf = u.astype(jnp.float32)
    cs = jnp.cumsum(uf, axis=1)
    cs = jnp.concatenate([jnp.zeros_like(cs[:, :1]), cs], axis=1)
    t = jnp.arange(S)
    outs = []
    for g, w in enumerate(POOL_WINDOWS):
        lo, hi = g * POOL_GROUP_DIM, (g + 1) * POOL_GROUP_DIM
        c = cs[:, :, lo:hi]
        start = jnp.maximum(t + 1 - w, 0)
        win_sum = c[:, 1:] - c[:, start]
        count = (t + 1 - start).astype(jnp.float32)
        outs.append(win_sum / count[None, :, None] - uf[:, :, lo:hi])
    d = jnp.stack(outs, axis=2)
    y = jnp.einsum('bsgc,gcd->bsgd', d, pool_w.astype(jnp.float32)).reshape(B, S, D_POOL)
    return (y * pool_scale.astype(jnp.float32)).astype(u.dtype)


def chunked_attention(q, k, v, q_gain, k_gain, rel_bias):
    B, S, _ = q.shape
    nc = S // CHUNK
    q = rmsnorm(q.reshape(B, S, N_HEADS, HEAD_DIM), q_gain)
    k = rmsnorm(k.reshape(B, S, N_HEADS, HEAD_DIM), k_gain)
    v = v.reshape(B, S, N_HEADS, HEAD_DIM)
    pad = N_LEFT_CHUNKS * CHUNK
    kp = jnp.pad(k, ((0, 0), (pad, 0), (0, 0), (0, 0)))
    vp = jnp.pad(v, ((0, 0), (pad, 0), (0, 0), (0, 0)))
    qc = q.reshape(B, nc, CHUNK, N_HEADS, HEAD_DIM)
    qpos = jnp.arange(CHUNK)[:, None] + pad
    kpos = jnp.arange(BAND)[None, :]
    rel_idx = jnp.clip(qpos - kpos, -REL_CLIP, REL_CLIP) + REL_CLIP
    bias = rel_bias.astype(jnp.float32)[:, rel_idx]
    scale = HEAD_DIM ** -0.5

    def one_chunk(c):
        qb = lax.dynamic_index_in_dim(qc, c, axis=1, keepdims=False)
        kb = lax.dynamic_slice_in_dim(kp, c * CHUNK, BAND, axis=1)
        vb = lax.dynamic_slice_in_dim(vp, c * CHUNK, BAND, axis=1)
        s = jnp.einsum('bqhd,bkhd->bhqk', qb, kb).astype(jnp.float32) * scale + bias
        valid = (c * CHUNK + kpos - pad) >= 0
        s = jnp.where(valid[None, None], s, NEG_INF)
        p = jax.nn.softmax(s, axis=-1)
        return jnp.einsum('bhqk,bkhd->bqhd', p.astype(vb.dtype), vb)

    o = lax.map(one_chunk, jnp.arange(nc))
    return o.transpose(1, 0, 2, 3, 4).reshape(B, S, D_ATTN)


def hybrid_mixer(h, w_in, q_gain, k_gain, rel_bias, pool_w, pool_scale, w_out):
    proj = h @ w_in
    q = proj[..., :D_ATTN]
    k = proj[..., D_ATTN:2 * D_ATTN]
    v = proj[..., 2 * D_ATTN:3 * D_ATTN]
    u = proj[..., 3 * D_ATTN:]
    a = chunked_attention(q, k, v, q_gain, k_gain, rel_bias)
    p = multiscale_pool(u, pool_w, pool_scale)
    return jnp.concatenate([a, p], axis=-1) @ w_out


def setup_inputs(seed: int = 0) -> dict:
    key = jax.random.key(seed)
    ks = jax.random.split(key, 20)
    f32 = jnp.float32
    L = DEPTH

    def nrm(k, shape, fan_in):
        return jax.random.normal(k, shape, f32) * fan_in ** -0.5

    def gain(k, shape):
        return 1.0 + 0.1 * jax.random.normal(k, shape, f32)

    return {
        "x": jax.random.normal(ks[0], (BATCH, SEQ, D_MODEL), f32),
        "ffn1_norm": gain(ks[1], (L, D_MODEL)),
        "ffn1_w_gate": nrm(ks[2], (L, D_MODEL, D_FF), D_MODEL),
        "ffn1_w_up": nrm(ks[3], (L, D_MODEL, D_FF), D_MODEL),
        "ffn1_w_down": nrm(ks[4], (L, D_FF, D_MODEL), D_FF),
        "mix_norm": gain(ks[5], (L, D_MODEL)),
        "w_in": nrm(ks[6], (L, D_MODEL, D_IN), D_MODEL),
        "q_norm": gain(ks[7], (L, HEAD_DIM)),
        "k_norm": gain(ks[8], (L, HEAD_DIM)),
        "rel_bias": 0.5 * jax.random.normal(ks[9], (L, N_HEADS, N_REL), f32),
        "pool_w": nrm(ks[10], (L, N_POOL_GROUPS, POOL_GROUP_DIM, POOL_GROUP_DIM), POOL_GROUP_DIM),
        "pool_scale": gain(ks[11], (L, D_POOL)),
        "w_out": nrm(ks[12], (L, D_MIX, D_MODEL), D_MIX),
        "ffn2_norm": gain(ks[13], (L, D_MODEL)),
        "ffn2_w_gate": nrm(ks[14], (L, D_MODEL, D_FF), D_MODEL),
        "ffn2_w_up": nrm(ks[15], (L, D_MODEL, D_FF), D_MODEL),
        "ffn2_w_down": nrm(ks[16], (L, D_FF, D_MODEL), D_FF),
        "final_norm": gain(ks[17], (L, D_MODEL)),
    }


def reference(x, ffn1_norm, ffn1_w_gate, ffn1_w_up, ffn1_w_down, mix_norm, w_in,
              q_norm, k_norm, rel_bias, pool_w, pool_scale, w_out,
              ffn2_norm, ffn2_w_gate, ffn2_w_up, ffn2_w_down, final_norm):
    for l in range(DEPTH):
        x = x + 0.5 * swiglu_ffn(rmsnorm(x, ffn1_norm[l]), ffn1_w_gate[l], ffn1_w_up[l], ffn1_w_down[l])
        x = x + hybrid_mixer(rmsnorm(x, mix_norm[l]), w_in[l], q_norm[l], k_norm[l], rel_bias[l],
                             pool_w[l], pool_scale[l], w_out[l])
        x = x + 0.5 * swiglu_ffn(rmsnorm(x, ffn2_norm[l]), ffn2_w_gate[l], ffn2_w_up[l], ffn2_w_down[l])
        x = rmsnorm(x, final_norm[l])
    return x
```

```cpp
#include <hip/hip_runtime.h>
#include <hip/hip_cooperative_groups.h>
#include <cstdio>
#include <cstdint>
#define MK_N_LAUNCHES 1
namespace pg8 {
#define PG8_LAS __attribute__((address_space(3)))
typedef unsigned short bf16_t;
typedef short bf16x8 __attribute__((ext_vector_type(8)));
typedef float f32x4 __attribute__((ext_vector_type(4)));
typedef unsigned u32x4 __attribute__((ext_vector_type(4)));
constexpr int BM = 256, BK = 64, HALF = 128, HTB = HALF * BK * 2  , STAGE_BYTES = 8 * HTB, NXCD = 8, WGM = 8;

__host__ __device__ __forceinline__ int lds_byte(int r, int c) { const int st = (r >> 4) * 2 + (c >> 5), rr = r & 15, cc = c & 31, ob = rr * 64 + cc * 2; return st * 1024 + (ob ^ (((ob >> 9) & 1) << 5)); }
__host__ __device__ __forceinline__ void stage_rc(int b, int& R, int& C) { const int st = b / 1024, sb = b % 1024, swz = sb ^ (((sb >> 9) & 1) << 5); R = (st >> 1) * 16 + swz / 64; C = (st & 1) * 32 + (swz % 64) / 2; }
__host__ __device__ __forceinline__ int perm32(int rho) { const int n = rho >> 4, i = rho & 15; return 8 * (i >> 2) + 4 * n + (i & 3); }

struct Unit { int pm, pn; };
struct Gemm { const bf16_t* A; const bf16_t* Bt; int M, N, K; };

struct StaticOrder {
    int nM, nN, nwg, G, c;
    __host__ __device__ void init(int M, int N, int G_, int c_) { nM = M / BM; nN = N / BM; nwg = nM * nN; G = G_; c = c_; }
    __host__ __device__ bool next(int i, Unit& u) const {
        const long L = (long)i * G + c; if (L >= nwg) return false;
        int wgid = (int)L; { const int q = nwg / NXCD, r = nwg % NXCD, xcd = wgid % NXCD, off = wgid / NXCD; wgid = (xcd < r ? xcd * (q + 1) : r * (q + 1) + (xcd - r) * q) + off; }
        const int nig = WGM * nN, gid = wgid / nig, fm = gid * WGM, gsz = (nM - fm) < WGM ? (nM - fm) : WGM;
        u.pm = fm + ((wgid % nig) % gsz); u.pn = (wgid % nig) / gsz; return true;
    }
    __device__ __forceinline__ void a_ready(const Unit&) const {}
    __device__ __forceinline__ void done(const Unit&) const {}
};

__device__ __forceinline__ unsigned cvt_pk_bf16(float lo, float hi) { unsigned r; asm volatile("v_cvt_pk_bf16_f32 %0, %1, %2" : "=v"(r) : "v"(lo), "v"(hi)); return r; }
typedef float f32x2 __attribute__((ext_vector_type(2)));
__device__ __forceinline__ float row_rinv(const float* ss, int row) {
    const f32x4* p = (const f32x4*)(ss + (size_t)row * 16);
    const f32x4 a = p[0], b = p[1], c = p[2], d = p[3];
    const float s = (((a[0] + a[1]) + (a[2] + a[3])) + ((b[0] + b[1]) + (b[2] + b[3]))) + (((c[0] + c[1]) + (c[2] + c[3])) + ((d[0] + d[1]) + (d[2] + d[3])));
    return __builtin_amdgcn_rsqf(s * (1.0f / 1024.0f) + 1e-6f);
}
__device__ __forceinline__ float silu_f(float x) { return x * __builtin_amdgcn_rcpf(1.0f + __builtin_amdgcn_exp2f(-1.4426950408889634f * x)); }

struct EpiSwiGLU {
    static constexpr bool PERM = true, AFTER_DRAIN = false;
    bf16_t* O; int ldc; const float* ss;
    __device__ __forceinline__ void operator()(const f32x4 (&acc)[2][2][4][2], const Unit& u, int wr, int wc, int fr, int fq) const {
        const int row0 = u.pm * BM + wr * 64 + fr, col0 = u.pn * 128 + wc * 32 + 8 * fq;
#pragma unroll
        for (int ai = 0; ai < 2; ++ai)
#pragma unroll
            for (int m = 0; m < 4; ++m) { const int row = row0 + ai * HALF + m * 16; const float ri = row_rinv(ss, row);
                const f32x4 g0 = acc[ai][0][m][0] * ri, g1 = acc[ai][0][m][1] * ri, u0 = acc[ai][1][m][0] * ri, u1 = acc[ai][1][m][1] * ri;
                float h[8];
#pragma unroll
                for (int j = 0; j < 4; ++j) { h[j] = silu_f(g0[j]) * u0[j]; h[4 + j] = silu_f(g1[j]) * u1[j]; }
                u32x4 w; w.x = cvt_pk_bf16(h[0], h[1]); w.y = cvt_pk_bf16(h[2], h[3]); w.z = cvt_pk_bf16(h[4], h[5]); w.w = cvt_pk_bf16(h[6], h[7]);
                *(u32x4*)(O + (size_t)row * ldc + col0) = w; }
    }
};

template <bool BASE_BF16> struct EpiRes {
    static constexpr bool PERM = true, AFTER_DRAIN = false;
    const float* base; bf16_t* xb; float* ss_out; float alpha;
    __device__ __forceinline__ void operator()(const f32x4 (&acc)[2][2][4][2], const Unit& u, int wr, int wc, int fr, int fq) const {
        const int row0 = u.pm * BM + wr * 64 + fr, col0 = u.pn * BM + wc * 32 + 8 * fq;
#pragma unroll
        for (int ai = 0; ai < 2; ++ai)
#pragma unroll
            for (int m = 0; m < 4; ++m) { const int row = row0 + ai * HALF + m * 16; float sq = 0.f;
#pragma unroll
                for (int bj = 0; bj < 2; ++bj) { const size_t off = (size_t)row * 1024 + col0 + bj * HALF;
                    f32x4 b0, b1;
                    if (BASE_BF16) { const u32x4 r = *(const u32x4*)(xb + off);
                        b0 = (f32x4){__builtin_bit_cast(float, r.x << 16), __builtin_bit_cast(float, r.x & 0xffff0000u), __builtin_bit_cast(float, r.y << 16), __builtin_bit_cast(float, r.y & 0xffff0000u)};
                        b1 = (f32x4){__builtin_bit_cast(float, r.z << 16), __builtin_bit_cast(float, r.z & 0xffff0000u), __builtin_bit_cast(float, r.w << 16), __builtin_bit_cast(float, r.w & 0xffff0000u)}; }
                    else { b0 = *(const f32x4*)(base + off); b1 = *(const f32x4*)(base + off + 4); }
                    const f32x4 v0 = b0 + acc[ai][bj][m][0] * alpha, v1 = b1 + acc[ai][bj][m][1] * alpha;
                    u32x4 w; w.x = cvt_pk_bf16(v0[0], v0[1]); w.y = cvt_pk_bf16(v0[2], v0[3]); w.z = cvt_pk_bf16(v1[0], v1[1]); w.w = cvt_pk_bf16(v1[2], v1[3]); *(u32x4*)(xb + off) = w;
                    sq += ((v0[0] * v0[0] + v0[1] * v0[1]) + (v0[2] * v0[2] + v0[3] * v0[3])) + ((v1[0] * v1[0] + v1[1] * v1[1]) + (v1[2] * v1[2] + v1[3] * v1[3])); }
                sq += __shfl_xor(sq, 16); sq += __shfl_xor(sq, 32);
                if (fq == 0) ss_out[(size_t)row * 16 + u.pn * 4 + wc] = sq; }
    }
};

struct EpiProj {
    static constexpr bool PERM = true, AFTER_DRAIN = false;
    bf16_t* O; const float* ss; const float* qg; const float* kg; float qscale;
    __device__ __forceinline__ void operator()(const f32x4 (&acc)[2][2][4][2], const Unit& u, int wr, int wc, int fr, int fq) const {
        const int row0 = u.pm * BM + wr * 64 + fr, col0 = u.pn * BM + wc * 64 + 8 * fq;
        const int kind = u.pn >> 1;
        float gn[2][8];
#pragma unroll
        for (int bj = 0; bj < 2; ++bj)
#pragma unroll
            for (int e = 0; e < 8; ++e) gn[bj][e] = 1.f;
        if (kind < 2) { const float* gp = kind == 0 ? qg : kg; const float sc = kind == 0 ? qscale : 1.f;
#pragma unroll
            for (int bj = 0; bj < 2; ++bj)
#pragma unroll
                for (int e = 0; e < 8; ++e) gn[bj][e] = gp[32 * bj + 8 * fq + e] * sc; }
#pragma unroll
        for (int ai = 0; ai < 2; ++ai)
#pragma unroll
            for (int m = 0; m < 4; ++m) { const int row = row0 + ai * HALF + m * 16; const float ri = row_rinv(ss, row);
                f32x4 v[2][2]; float sq = 0.f;
#pragma unroll
                for (int bj = 0; bj < 2; ++bj)
#pragma unroll
                    for (int n = 0; n < 2; ++n) { v[bj][n] = acc[ai][bj][m][n] * ri; const f32x4 t = v[bj][n]; sq += (t[0] * t[0] + t[1] * t[1]) + (t[2] * t[2] + t[3] * t[3]); }
                float hr = 1.f;
                if (kind < 2) { sq += __shfl_xor(sq, 16); sq += __shfl_xor(sq, 32); hr = __builtin_amdgcn_rsqf(sq * (1.0f / 64.0f) + 1e-6f); }
#pragma unroll
                for (int bj = 0; bj < 2; ++bj) { const f32x4 a = v[bj][0], b = v[bj][1]; u32x4 w;
                    w.x = cvt_pk_bf16(a[0] * hr * gn[bj][0], a[1] * hr * gn[bj][1]); w.y = cvt_pk_bf16(a[2] * hr * gn[bj][2], a[3] * hr * gn[bj][3]);
                    w.z = cvt_pk_bf16(b[0] * hr * gn[bj][4], b[1] * hr * gn[bj][5]); w.w = cvt_pk_bf16(b[2] * hr * gn[bj][6], b[3] * hr * gn[bj][7]);
                    *(u32x4*)(O + (size_t)row * 1536 + col0 + bj * 32) = w; } }
    }
};

struct EpiVT {
    static constexpr bool PERM = true, AFTER_DRAIN = false;
    bf16_t* O; int ldc; const float* ss;
    __device__ __forceinline__ void operator()(const f32x4 (&acc)[2][2][4][2], const Unit& u, int wr, int wc, int fr, int fq) const {
        const int row0 = u.pm * BM + wr * 64 + fr, col0 = u.pn * BM + wc * 32 + 8 * fq;
        float ri[2][8];
#pragma unroll
        for (int bj = 0; bj < 2; ++bj)
#pragma unroll
            for (int e = 0; e < 8; ++e) ri[bj][e] = row_rinv(ss, col0 + bj * HALF + e);
#pragma unroll
        for (int ai = 0; ai < 2; ++ai)
#pragma unroll
            for (int m = 0; m < 4; ++m) { const int row = row0 + ai * HALF + m * 16;
#pragma unroll
                for (int bj = 0; bj < 2; ++bj) { const f32x4 a = acc[ai][bj][m][0], b = acc[ai][bj][m][1]; u32x4 w;
                    w.x = cvt_pk_bf16(a[0] * ri[bj][0], a[1] * ri[bj][1]); w.y = cvt_pk_bf16(a[2] * ri[bj][2], a[3] * ri[bj][3]);
                    w.z = cvt_pk_bf16(b[0] * ri[bj][4], b[1] * ri[bj][5]); w.w = cvt_pk_bf16(b[2] * ri[bj][6], b[3] * ri[bj][7]);
                    *(u32x4*)(O + (size_t)row * ldc + col0 + bj * HALF) = w; } }
    }
};

template <class Epi, class Sched, bool ALIGN_EPI = false, bool SP2 = false>
__device__ __forceinline__ void gemm_phase(PG8_LAS unsigned char* lds, const Gemm g, const Sched& S, const Epi& E) {
    const int tid = threadIdx.x, wid = __builtin_amdgcn_readfirstlane(tid >> 6), lane = tid & 63, wr = wid >> 2, wc = wid & 3, fr = lane & 15, fq = lane >> 4;
    const int K = g.K, nt = K / BK;
    unsigned voffA[2], voffB[2];
#pragma unroll
    for (int i = 0; i < 2; ++i) { int R, C; stage_rc(tid * 16 + i * 8192, R, C); const int Rb = Epi::PERM ? ((R & ~31) + perm32(R & 31)) : R;
        voffA[i] = (unsigned)(R * K + C) * 2u; voffB[i] = (unsigned)(Rb * K + C) * 2u; }
    const size_t kstep = (size_t)(BK * 2);
    const size_t hstep = (size_t)HALF * K * 2;
    const size_t tstep = 2 * hstep;
    const unsigned ldsw = (unsigned)wid * 1024u;
    const int aoff = lds_byte(wr * 64 + fr, fq * 8), boff = lds_byte(wc * 32 + fr, fq * 8);
#define PG8_SA(b, h) (((b) * 2 + (h)) * HTB)
#define PG8_SB(b, h) ((4 + (b) * 2 + (h)) * HTB)
#define PG8_STAGE(bufoff, gbase, voff) do { _Pragma("unroll") for (int _i = 0; _i < 2; ++_i) \
        __builtin_amdgcn_global_load_lds((const unsigned*)((const char*)(gbase) + (voff)[_i]), (PG8_LAS unsigned*)(lds + (bufoff) + ldsw + _i * 8192), 16, 0, 0); } while (0)
#define PG8_LDA(dst, b, h) do { _Pragma("unroll") for (int m = 0; m < 4; ++m) _Pragma("unroll") for (int k = 0; k < 2; ++k) dst[m][k] = *(const PG8_LAS bf16x8*)(lds + PG8_SA(b, h) + aoff + m * 2048 + k * 1024); } while (0)
#define PG8_LDB(dst, b, h) do { _Pragma("unroll") for (int n = 0; n < 2; ++n) _Pragma("unroll") for (int k = 0; k < 2; ++k) dst[n][k] = *(const PG8_LAS bf16x8*)(lds + PG8_SB(b, h) + boff + n * 2048 + k * 1024); } while (0)
#define PG8_MMA(ai, bj, At, Bt) do { __builtin_amdgcn_s_setprio(1); _Pragma("unroll") for (int m = 0; m < 4; ++m) _Pragma("unroll") for (int n = 0; n < 2; ++n) _Pragma("unroll") for (int k = 0; k < 2; ++k) \
        acc[ai][bj][m][n] = __builtin_amdgcn_mfma_f32_16x16x32_bf16(Bt[n][k], At[m][k], acc[ai][bj][m][n], 0, 0, 0); __builtin_amdgcn_s_setprio(0); } while (0)
#define PG8_WAIT_V(n) asm volatile("s_waitcnt vmcnt(" #n ")" ::: "memory")
#define PG8_WAIT_L(n) asm volatile("s_waitcnt lgkmcnt(" #n ")" ::: "memory")
#define PG8_BAR __builtin_amdgcn_s_barrier()
#define PG8_SCHED __builtin_amdgcn_sched_barrier(0)
    Unit cur, nxt; int ui = 0;
    if (!S.next(0, cur)) return;
    f32x4 acc[2][2][4][2];
#pragma unroll
    for (int a = 0; a < 2; ++a)
#pragma unroll
        for (int b = 0; b < 2; ++b)
#pragma unroll
            for (int m = 0; m < 4; ++m)
#pragma unroll
                for (int n = 0; n < 2; ++n) acc[a][b][m][n] = (f32x4){0.f, 0.f, 0.f, 0.f};
    bf16x8 At[4][2], B0[2][2], B1[2][2];
    const char* cA = (const char*)g.A + (size_t)cur.pm * tstep; const char* cB = (const char*)g.Bt + (size_t)cur.pn * tstep;
    S.a_ready(cur);
    if constexpr (SP2) {
        PG8_STAGE(PG8_SB(0, 0), cB, voffB); PG8_STAGE(PG8_SB(0, 1), cB + hstep, voffB); PG8_STAGE(PG8_SA(0, 0), cA, voffA); PG8_STAGE(PG8_SA(0, 1), cA + hstep, voffA);
        if (wr == 1) PG8_BAR;
        PG8_WAIT_V(2); PG8_BAR;
        PG8_STAGE(PG8_SB(1, 0), cB + kstep, voffB); PG8_STAGE(PG8_SA(1, 0), cA + kstep, voffA); PG8_STAGE(PG8_SB(1, 1), cB + hstep + kstep, voffB);
        PG8_WAIT_V(6); PG8_BAR;
    } else {
        PG8_STAGE(PG8_SB(0, 0), cB, voffB); PG8_STAGE(PG8_SA(0, 0), cA, voffA); PG8_STAGE(PG8_SB(0, 1), cB + hstep, voffB); PG8_STAGE(PG8_SA(0, 1), cA + hstep, voffA);
        if (wr == 1) PG8_BAR;
        PG8_WAIT_V(4); PG8_BAR;
        PG8_STAGE(PG8_SB(1, 0), cB + kstep, voffB); PG8_STAGE(PG8_SA(1, 0), cA + kstep, voffA); PG8_STAGE(PG8_SB(1, 1), cB + hstep + kstep, voffB);
        PG8_WAIT_V(6); PG8_BAR;
    }
    for (;;) {
        const bool has_next = S.next(ui + 1, nxt);
        const char* nA = has_next ? (const char*)g.A + (size_t)nxt.pm * tstep : cA; const char* nB = has_next ? (const char*)g.Bt + (size_t)nxt.pn * tstep : cB;
        for (int t = 0; t < nt; t += 2) {
            const bool last = (t == nt - 2);
            const char* a1 = cA + (size_t)(t + 1) * kstep;
            const char* a2 = last ? nA : cA + (size_t)(t + 2) * kstep; const char* b2 = last ? nB : cB + (size_t)(t + 2) * kstep;
            const char* a3 = a2 + kstep; const char* b3 = b2 + kstep;
            if (last && has_next) S.a_ready(nxt);
            if constexpr (SP2) {
            PG8_LDB(B0, 0, 0); PG8_LDB(B1, 0, 1); PG8_SCHED; PG8_LDA(At, 0, 0); PG8_STAGE(PG8_SA(1, 1), a1 + hstep, voffA);
            PG8_WAIT_V(8); PG8_WAIT_L(0); PG8_BAR; PG8_MMA(0, 0, At, B0); PG8_MMA(0, 1, At, B1); PG8_BAR; PG8_SCHED;
            PG8_LDA(At, 0, 1); PG8_STAGE(PG8_SB(0, 0), b2, voffB); PG8_STAGE(PG8_SB(0, 1), b2 + hstep, voffB); PG8_STAGE(PG8_SA(0, 0), a2, voffA);
            PG8_WAIT_V(8); PG8_WAIT_L(0); PG8_BAR; PG8_MMA(1, 0, At, B0); PG8_MMA(1, 1, At, B1); PG8_BAR; PG8_SCHED;
            PG8_LDB(B0, 1, 0); PG8_LDB(B1, 1, 1); PG8_SCHED; PG8_LDA(At, 1, 0); PG8_STAGE(PG8_SA(0, 1), a2 + hstep, voffA);
            PG8_WAIT_V(8); PG8_WAIT_L(0); PG8_BAR; PG8_MMA(0, 0, At, B0); PG8_MMA(0, 1, At, B1); PG8_BAR; PG8_SCHED;
            PG8_LDA(At, 1, 1); PG8_STAGE(PG8_SB(1, 0), b3, voffB); PG8_STAGE(PG8_SB(1, 1), b3 + hstep, voffB); PG8_STAGE(PG8_SA(1, 0), a3, voffA);
            PG8_WAIT_V(8); PG8_WAIT_L(0); PG8_BAR; PG8_MMA(1, 0, At, B0); PG8_MMA(1, 1, At, B1); PG8_BAR; PG8_SCHED;
            } else {
            PG8_LDB(B0, 0, 0); PG8_SCHED; PG8_LDA(At, 0, 0); PG8_STAGE(PG8_SA(1, 1), a1 + hstep, voffA);
            PG8_WAIT_L(8); PG8_BAR; PG8_WAIT_L(0); PG8_MMA(0, 0, At, B0); PG8_BAR; PG8_SCHED;
            PG8_LDB(B1, 0, 1); PG8_STAGE(PG8_SB(0, 0), b2, voffB);
            PG8_BAR; PG8_WAIT_L(0); PG8_MMA(0, 1, At, B1); PG8_BAR;
            PG8_LDA(At, 0, 1); PG8_STAGE(PG8_SA(0, 0), a2, voffA);
            PG8_BAR; PG8_WAIT_L(0); PG8_MMA(1, 0, At, B0); PG8_BAR; PG8_SCHED;
            PG8_STAGE(PG8_SB(0, 1), b2 + hstep, voffB);
            PG8_WAIT_V(6); PG8_BAR; PG8_MMA(1, 1, At, B1); PG8_BAR;
            PG8_LDB(B0, 1, 0); PG8_SCHED; PG8_LDA(At, 1, 0); PG8_STAGE(PG8_SA(0, 1), a2 + hstep, voffA);
            PG8_WAIT_L(8); PG8_BAR; PG8_WAIT_L(0); PG8_MMA(0, 0, At, B0); PG8_BAR; PG8_SCHED;
            PG8_LDB(B1, 1, 1); PG8_STAGE(PG8_SB(1, 0), b3, voffB);
            PG8_BAR; PG8_WAIT_L(0); PG8_MMA(0, 1, At, B1); PG8_BAR;
            PG8_LDA(At, 1, 1); PG8_STAGE(PG8_SA(1, 0), a3, voffA);
            PG8_BAR; PG8_WAIT_L(0); PG8_MMA(1, 0, At, B0); PG8_BAR; PG8_SCHED;
            PG8_STAGE(PG8_SB(1, 1), b3 + hstep, voffB);
            PG8_WAIT_V(6); PG8_BAR; PG8_MMA(1, 1, At, B1); PG8_BAR;
            }
        }
        if constexpr (ALIGN_EPI) { if (wr == 0) PG8_BAR; }
        if constexpr (!Epi::AFTER_DRAIN) { E(acc, cur, wr, wc, fr, fq); S.done(cur); }
        if (!has_next) break;
#pragma unroll
        for (int a = 0; a < 2; ++a)
#pragma unroll
            for (int b = 0; b < 2; ++b)
#pragma unroll
                for (int m = 0; m < 4; ++m)
#pragma unroll
                    for (int n = 0; n < 2; ++n) acc[a][b][m][n] = (f32x4){0.f, 0.f, 0.f, 0.f};
        cur = nxt; cA = nA; cB = nB; ++ui;
        if constexpr (ALIGN_EPI) { if (wr == 1) PG8_BAR; }
    }
    PG8_WAIT_V(0);
    if constexpr (!ALIGN_EPI) { if (wr == 0) PG8_BAR; }
    PG8_BAR;
    if constexpr (Epi::AFTER_DRAIN) { E.fused(acc, cur, wr, wc, fr, fq, lds, wid, lane); S.done(cur); }
#undef PG8_SA
#undef PG8_SB
#undef PG8_STAGE
#undef PG8_LDA
#undef PG8_LDB
#undef PG8_MMA
#undef PG8_WAIT_V
#undef PG8_WAIT_L
#undef PG8_BAR
#undef PG8_SCHED
}
}

namespace cg = cooperative_groups;
#define GAS __attribute__((address_space(1)))
#define LAS __attribute__((address_space(3)))
typedef unsigned short bf16;
typedef unsigned v4u __attribute__((ext_vector_type(4)));
typedef unsigned v2u __attribute__((ext_vector_type(2)));
typedef float f32x4 __attribute__((ext_vector_type(4)));
typedef short bf16x8 __attribute__((ext_vector_type(8)));
typedef float f32x16 __attribute__((ext_vector_type(16)));

constexpr int NWAVES = 8;
constexpr int BATCH = 8, SEQ = 4096, D = 1024, FF = 2816, DA = 512, HD = 64, NH = 8, DP = 512, NREL = 257;
constexpr int M = BATCH * SEQ;
constexpr int NPROJ = 1536;
constexpr float LOG2E = 1.4426950408889634f;
#ifndef MK_N_LAUNCHES
#define MK_N_LAUNCHES 1
#endif
constexpr int N_PHASES = 9;

constexpr size_t MiB = 1u << 20;
constexpr size_t WS_SS0 = 2 * MiB, WS_SS1 = 4 * MiB, WS_SS2 = 6 * MiB, WS_SS3 = 8 * MiB;
constexpr size_t WS_WGU1 = 10 * MiB, WS_WD1 = 21 * MiB, WS_WIN = 27 * MiB, WS_WV = 30 * MiB, WS_WOUT = 31 * MiB, WS_WGU2 = 33 * MiB, WS_WD2 = 44 * MiB;
constexpr size_t WS_XB = 50 * MiB;
constexpr size_t WS_H = 114 * MiB;
constexpr size_t WS_QKU = 114 * MiB, WS_VT = 210 * MiB, WS_CAT = 242 * MiB, WS_END = 306 * MiB;
static_assert(WS_H + (size_t)M * FF * 2 <= WS_END && WS_QKU + (size_t)M * NPROJ * 2 <= WS_VT && WS_VT + (size_t)512 * M * 2 <= WS_CAT && WS_CAT + (size_t)M * 1024 * 2 <= WS_END, "ws map");

constexpr int STAGE_LDS = 131072, LDS_BYTES = 143360;

#define LDS_WAIT() asm volatile("s_waitcnt lgkmcnt(0)" ::: "memory")
__device__ __forceinline__ unsigned f2bf(float f) { unsigned u = __builtin_bit_cast(unsigned, f); return (u + 0x7fffu + ((u >> 16) & 1u)) >> 16; }
__device__ __forceinline__ unsigned pk2(float lo, float hi) { return f2bf(lo) | (f2bf(hi) << 16); }
__device__ __forceinline__ float bf2f(unsigned short b) { return __builtin_bit_cast(float, (unsigned)b << 16); }
__device__ __forceinline__ float wave_sum(float v) {
#pragma unroll
    for (int o = 1; o < 64; o <<= 1) v += __shfl_xor(v, o);
    return v;
}

#define XB_TMO      128
#define XB_XCNT(j)  (256  + 64 * (j))
#define XB_XSUB(j)  (1280 + 64 * (j))
#define XB_XGEN(j)  (2304 + 64 * (j))
#define XB_TOP      3328
#define XB_TOPGEN   3392
#define XCD_BAR_WORDS 3456
#define XB_SPIN_CAP (1u << 18)

__device__ __forceinline__ unsigned xb_ld(unsigned* p)              { return __hip_atomic_load(p, __ATOMIC_RELAXED, __HIP_MEMORY_SCOPE_AGENT); }
__device__ __forceinline__ unsigned xb_add(unsigned* p, unsigned v) { return __hip_atomic_fetch_add(p, v, __ATOMIC_RELAXED, __HIP_MEMORY_SCOPE_AGENT); }
__device__ __forceinline__ unsigned xb_xcc_id() { return (unsigned)__builtin_amdgcn_s_getreg((3 << 11) | 20) & 0xFu; }
#define XB_SPIN(cond, bar) do { unsigned _sp = 0; while (cond) { __builtin_amdgcn_s_sleep(1); \
    if ((++_sp & 255u) == 0u) { if (xb_ld(&(bar)[XB_TMO])) break; if (_sp > XB_SPIN_CAP) { atomicAdd(&(bar)[XB_TMO], 1u); break; } } } } while (0)

struct XcdBarrier {
    unsigned* bar; unsigned x;
    volatile LAS unsigned* st;
};

__device__ __forceinline__ XcdBarrier xcd_barrier_post(unsigned* bar, volatile LAS unsigned* st) {
    XcdBarrier b; b.bar = bar; b.x = xb_xcc_id(); b.st = st;
    if (threadIdx.x == 0) (void)xb_add(&bar[XB_XCNT(b.x)], 1u);
    return b;
}
__device__ __forceinline__ void xcd_barrier_complete(unsigned* bar, unsigned x, unsigned& nloc, unsigned& nx) {
    const unsigned G = gridDim.x * gridDim.y * gridDim.z;
    unsigned sum, cnt, mine, sp = 0u;
    for (;;) {
        sum = 0u; cnt = 0u; mine = 0u;
#pragma unroll
        for (unsigned j = 0; j < 16; ++j) { const unsigned c = xb_ld(&bar[XB_XCNT(j)]); sum += c; cnt += (c > 0u) ? 1u : 0u; mine = (j == x) ? c : mine; }
        if (sum == G) break;
        __builtin_amdgcn_s_sleep(1);
        if ((++sp & 255u) == 0u) { if (xb_ld(&bar[XB_TMO])) break; if (sp > XB_SPIN_CAP) { atomicAdd(&bar[XB_TMO], 1u); break; } }
    }
    nloc = mine > 0u ? mine : 1u; nx = cnt > 0u ? cnt : 1u;
}

__device__ __forceinline__ void xcd_barrier(const XcdBarrier& b) {
    asm volatile("s_waitcnt vmcnt(0)" ::: "memory");
    __syncthreads();
    if (threadIdx.x == 0) {
        unsigned* bar = b.bar;
        __builtin_amdgcn_s_waitcnt(0);
        unsigned nloc = b.st[0], nx = b.st[1];
        if (nloc == 0u) { xcd_barrier_complete(bar, b.x, nloc, nx); b.st[0] = nloc; b.st[1] = nx; }
        const unsigned old = xb_add(&bar[XB_XSUB(b.x)], 1u);
        const unsigned gen = old / nloc;
        if (old + 1u == (gen + 1u) * nloc) {
            __builtin_amdgcn_fence(__ATOMIC_RELEASE, "agent");
            asm volatile("s_waitcnt vmcnt(0)" ::: "memory");
            const unsigned og = xb_add(&bar[XB_TOP], 1u);
            const unsigned tg = og / nx;
            if (og + 1u == (tg + 1u) * nx) xb_add(&bar[XB_TOPGEN], 1u);
            else XB_SPIN(xb_ld(&bar[XB_TOPGEN]) == tg, bar);
            __builtin_amdgcn_fence(__ATOMIC_ACQUIRE, "agent");
            xb_add(&bar[XB_XGEN(b.x)], 1u);
            asm volatile("s_waitcnt vmcnt(0)" ::: "memory");
        } else {
            XB_SPIN(xb_ld(&bar[XB_XGEN(b.x)]) == gen, bar);
            __builtin_amdgcn_fence(__ATOMIC_ACQUIRE, "agent");
            asm volatile("s_waitcnt vmcnt(0)" ::: "memory");
        }
    }
    __syncthreads();
}

struct Frame {
    LAS unsigned char* lds;
    int tid, lane, wave, vcu, G;
    const float *x, *n1, *wg1, *wu1, *wd1, *nm, *win, *qn, *kn, *relb, *poolw, *pools, *wout, *n2, *wg2, *wu2, *wd2, *nf;
    float* out;
    float *SS0, *SS1, *SS2, *SS3;
    bf16 *Wgu1, *Wd1, *Win, *Wv, *Wout, *Wgu2, *Wd2, *XB, *H, *QKU, *VT, *CAT;
};

__device__ __forceinline__ void transpose_item(const float* W, int Nsrc, int k0, int srccol0, const float* gain, bf16* WT, int Kdst, int dstrow0, LAS float* scr, int lane) {
#pragma unroll
    for (int i = 0; i < 32; ++i) { const int kk = 2 * i + (lane >> 5); const float g = gain ? gain[k0 + kk] : 1.f; scr[kk * 33 + (lane & 31)] = W[(size_t)(k0 + kk) * Nsrc + srccol0 + (lane & 31)] * g; }
    LDS_WAIT(); asm volatile("" ::: "memory");
    const int c = lane & 7;
#pragma unroll
    for (int j = 0; j < 4; ++j) { const int n = (lane >> 3) + 8 * j; const LAS float* s = scr + (8 * c) * 33 + n;
        v4u o; o.x = pk2(s[0 * 33], s[1 * 33]); o.y = pk2(s[2 * 33], s[3 * 33]); o.z = pk2(s[4 * 33], s[5 * 33]); o.w = pk2(s[6 * 33], s[7 * 33]);
        *(v4u*)(WT + (size_t)(dstrow0 + n) * Kdst + k0 + 8 * c) = o; }
    LDS_WAIT(); asm volatile("" ::: "memory");
}
__device__ __forceinline__ void gu_item(const float* wg, const float* wu, const float* gain, bf16* WT, int item, LAS float* scr, int lane) {
    const int nblk = (2 * FF) / 32, kb = item / nblk, nb = item % nblk, n0 = 32 * nb;
    const int pn = n0 >> 8, bj = (n0 >> 7) & 1, i0 = n0 & 127;
    transpose_item(bj ? wu : wg, FF, 64 * kb, 128 * pn + i0, gain, WT, D, n0, scr, lane);
}
__device__ __forceinline__ void plain_item(const float* W, int K, int N, int srccol_off, int Nsrc, const float* gain, bf16* WT, int item, LAS float* scr, int lane) {
    const int nblk = N / 32, kb = item / nblk, nb = item % nblk;
    transpose_item(W, Nsrc, 64 * kb, srccol_off + 32 * nb, gain, WT, K, 32 * nb, scr, lane);
}
__device__ __forceinline__ void qk_item(const float* win, const float* gain, bf16* WT, int item, LAS float* scr, int lane) {
    const int nblk = 1024 / 32, kb = item / nblk, nb = item % nblk, n0 = 32 * nb;
    const int pn = n0 >> 8, bj = (n0 >> 7) & 1, wc = (n0 >> 5) & 3;
    transpose_item(win, 2048, 64 * kb, 256 * pn + 64 * wc + 32 * bj, gain, WT, D, n0, scr, lane);
}

__device__ __forceinline__ void p0_prologue(Frame& F) {
    if (F.wave < 4) {
        const int xw = F.vcu * 4 + F.wave, NXW = F.G * 4;
        for (int m = 4 * xw; m < M; m += 4 * NXW) {
            const f32x4* xr = (const f32x4*)(F.x + (size_t)m * D) + F.lane; f32x4 v[16]; float s[4] = {0.f, 0.f, 0.f, 0.f};
#pragma unroll
            for (int j = 0; j < 16; ++j) v[j] = xr[64 * j];
#pragma unroll
            for (int j = 0; j < 16; ++j) s[j >> 2] += (v[j][0] * v[j][0] + v[j][1] * v[j][1]) + (v[j][2] * v[j][2] + v[j][3] * v[j][3]);
#pragma unroll
            for (int r = 0; r < 4; ++r) s[r] = wave_sum(s[r]);
            v2u* o8 = (v2u*)(F.XB + (size_t)m * D) + F.lane;
#pragma unroll
            for (int j = 0; j < 16; ++j) { v2u w; w.x = pk2(v[j][0], v[j][1]); w.y = pk2(v[j][2], v[j][3]); o8[64 * j] = w; }
            const int r = F.lane >> 4; const float sv = r == 0 ? s[0] : (r == 1 ? s[1] : (r == 2 ? s[2] : s[3]));
            F.SS0[(size_t)m * 16 + F.lane] = (F.lane & 15) == 0 ? sv : 0.f;
        }
        return;
    }
    LAS float* scr = (LAS float*)(F.lds + F.wave * 16384);
    const int gw = F.vcu * 4 + (F.wave - 4), NGW = F.G * 4;
    constexpr int I_GU = (D / 64) * (2 * FF / 32), I_D = (FF / 64) * (D / 32), I_QK = (D / 64) * (1024 / 32), I_V = (D / 64) * (512 / 32), I_O = (D / 64) * (D / 32);
    constexpr int NITEMS = 2 * I_GU + 2 * I_D + I_QK + I_V + I_O;
    for (int it = gw; it < (D / 4) * 8; it += NGW) {
        const int k0 = (it >> 3) * 4, cb = it & 7, ucol = cb * 64 + F.lane, g = cb >> 1, d = ucol & 127;
        const float* wrow = F.win + (size_t)k0 * 2048 + 1536 + g * 128; const float* pw = F.poolw + (size_t)g * 128 * 128 + d;
        float a0 = 0.f, a1 = 0.f, a2 = 0.f, a3 = 0.f;
#pragma unroll 16
        for (int c = 0; c < 128; ++c) { const float p = pw[(size_t)c * 128]; a0 += wrow[c] * p; a1 += wrow[2048 + c] * p; a2 += wrow[4096 + c] * p; a3 += wrow[6144 + c] * p; }
        const float ps = F.pools[ucol];
        const int t = ucol >> 8, wc = (ucol >> 6) & 3, bj = (ucol >> 5) & 1, i = ucol & 31;
        v2u w; w.x = pk2(a0 * ps * F.nm[k0], a1 * ps * F.nm[k0 + 1]); w.y = pk2(a2 * ps * F.nm[k0 + 2], a3 * ps * F.nm[k0 + 3]);
        *(v2u*)(F.Win + (size_t)(1024 + 256 * t + 128 * bj + 32 * wc + i) * D + k0) = w;
    }
    for (int it = gw; it < NITEMS; it += NGW) {
        int r = it;
        if (r < I_GU) { gu_item(F.wg1, F.wu1, F.n1, F.Wgu1, r, scr, F.lane); continue; } r -= I_GU;
        if (r < I_GU) { gu_item(F.wg2, F.wu2, F.n2, F.Wgu2, r, scr, F.lane); continue; } r -= I_GU;
        if (r < I_D) { plain_item(F.wd1, FF, D, 0, D, nullptr, F.Wd1, r, scr, F.lane); continue; } r -= I_D;
        if (r < I_D) { plain_item(F.wd2, FF, D, 0, D, nullptr, F.Wd2, r, scr, F.lane); continue; } r -= I_D;
        if (r < I_QK) { qk_item(F.win, F.nm, F.Win, r, scr, F.lane); continue; } r -= I_QK;
        if (r < I_V) { plain_item(F.win, D, 512, 1024, 2048, F.nm, F.Wv, r, scr, F.lane); continue; } r -= I_V;
        plain_item(F.wout, D, D, 0, D, nullptr, F.Wout, r, scr, F.lane);
    }
}

__device__ __forceinline__ void pool_phase(Frame& F) {
    const int gt = F.vcu * (NWAVES * 64) + F.tid, NT = F.G * NWAVES * 64;
    for (int it = gt; it < M * 64; it += NT) {
        const int tok = it >> 6, cgp = it & 63, s = tok & (SEQ - 1), g = cgp >> 4, w = 2 << g;
        const int n = (s + 1 < w) ? s + 1 : w;
        const bf16* up = F.QKU + (size_t)tok * NPROJ + 1024 + cgp * 8;
        float acc[8], cur[8];
        { const bf16x8 v = *(const bf16x8*)up;
#pragma unroll
          for (int e = 0; e < 8; ++e) { cur[e] = bf2f((unsigned short)v[e]); acc[e] = cur[e]; } }
        for (int j = 1; j < n; ++j) { const bf16x8 v = *(const bf16x8*)(up - (size_t)j * NPROJ);
#pragma unroll
            for (int e = 0; e < 8; ++e) acc[e] += bf2f((unsigned short)v[e]); }
        const float inv = 1.0f / (float)n;
        v4u o; o.x = pk2(acc[0] * inv - cur[0], acc[1] * inv - cur[1]); o.y = pk2(acc[2] * inv - cur[2], acc[3] * inv - cur[3]);
        o.z = pk2(acc[4] * inv - cur[4], acc[5] * inv - cur[5]); o.w = pk2(acc[6] * inv - cur[6], acc[7] * inv - cur[7]);
        *(v4u*)(F.CAT + (size_t)tok * 1024 + 512 + cgp * 8) = o;
    }
}

__device__ __forceinline__ unsigned cvtpk_rne(float lo, float hi) { unsigned r; asm volatile("v_cvt_pk_bf16_f32 %0, %1, %2" : "=v"(r) : "v"(lo), "v"(hi)); return r; }
__device__ __forceinline__ void attn_item(const bf16* QKU, const bf16* VT, bf16* CAT, const LAS float* btab, LAS unsigned char* wl, int b, int c, int h, int half, int lane) {
    const int r32 = lane & 31, hi = lane >> 5;
    const int qi = half * 32 + r32, tokq = b * SEQ + c * 64 + qi;
    bf16x8 qf[4];
    { const bf16* qp = QKU + (size_t)tokq * NPROJ + h * 64 + hi * 8;
#pragma unroll
      for (int d0 = 0; d0 < 4; ++d0) qf[d0] = *(const bf16x8*)(qp + d0 * 16); }
    const int pi = (r32 & 16) + 8 * ((r32 >> 2) & 1) + (r32 & 3) + 4 * ((r32 >> 3) & 1);
    float m_run = -1e30f, l_run = 0.f; f32x16 o0 = {}, o1 = {};
    const int t0 = c >= 8 ? 0 : 8 - c;
    const int lrow = lane >> 3, lch = lane & 7;
    const bf16* kg = QKU + (size_t)(b * SEQ + (c - 8) * 64 + lrow) * NPROJ + 512 + h * 64 + lch * 8;
    const bf16* vg = VT + (size_t)(h * 64 + lrow) * M + b * SEQ + (c - 8) * 64 + lch * 8;
    const int wofs = lrow * 128 + ((lch ^ lrow) << 4);
    const int kofs = pi * 128, ksw = pi & 7, vofs = 8192 + r32 * 128, vsw = r32 & 7;
#define ATT_GLOADK(SK, t) do { const bf16* kp_ = kg + (size_t)(t) * 64 * NPROJ; _Pragma("unroll") for (int i = 0; i < 8; ++i) SK[i] = *(const v4u*)(kp_ + (size_t)i * 8 * NPROJ); } while (0)
#define ATT_GLOADV(SV, t) do { const bf16* vp_ = vg + (t) * 64; _Pragma("unroll") for (int i = 0; i < 8; ++i) SV[i] = *(const v4u*)(vp_ + (size_t)i * 8 * M); } while (0)
#define ATT_LWRITE(S, base) do { _Pragma("unroll") for (int i = 0; i < 8; ++i) *(LAS v4u*)(wl + (base) + wofs + i * 1024) = S[i]; } while (0)
#define ATT_KFRAGS(KF0, KF1) do { _Pragma("unroll") for (int d0 = 0; d0 < 4; ++d0) { KF0[d0] = *(const LAS bf16x8*)(wl + kofs + (((2 * d0 + hi) ^ ksw) << 4)); KF1[d0] = *(const LAS bf16x8*)(wl + 4096 + kofs + (((2 * d0 + hi) ^ ksw) << 4)); } } while (0)
#define ATT_VFRAGS(VF) do { _Pragma("unroll") for (int ks = 0; ks < 4; ++ks) { VF[ks][0] = *(const LAS bf16x8*)(wl + vofs + (((2 * ks + hi) ^ vsw) << 4)); VF[ks][1] = *(const LAS bf16x8*)(wl + 4096 + vofs + (((2 * ks + hi) ^ vsw) << 4)); } } while (0)
#define ATT_COMPUTE(KF0, KF1, VF, t, MORE) do { \
        f32x16 p0 = {}, p1 = {}; \
        ATT_KFRAGS(KF0, KF1); \
        _Pragma("unroll") for (int d0 = 0; d0 < 4; ++d0) { p0 = __builtin_amdgcn_mfma_f32_32x32x16_bf16(KF0[d0], qf[d0], p0, 0, 0, 0); p1 = __builtin_amdgcn_mfma_f32_32x32x16_bf16(KF1[d0], qf[d0], p1, 0, 0, 0); } \
        if (MORE) ATT_GLOADV(sv, (t) + 1); \
        if ((t) >= 6) { const int base_ = 512 - 64 * (t) + qi - 8 * hi + 128; \
            _Pragma("unroll") for (int r = 0; r < 16; ++r) { const int off_ = 16 * (r >> 3) + (r & 7); int i0 = base_ - off_, i1 = base_ - 32 - off_; i0 = i0 > 256 ? 256 : i0; i1 = i1 > 256 ? 256 : i1; \
                p0[r] += btab[i0]; p1[r] += btab[i1]; } } \
        float mx = fmaxf(p0[0], p1[0]); \
        _Pragma("unroll") for (int r = 1; r < 16; ++r) mx = fmaxf(mx, fmaxf(p0[r], p1[r])); \
        mx = fmaxf(mx, __shfl_xor(mx, 32)); \
        const float m_new = fmaxf(m_run, mx), alpha = __builtin_amdgcn_exp2f(m_run - m_new); m_run = m_new; \
        float s_ = 0.f; \
        _Pragma("unroll") for (int r = 0; r < 16; ++r) { p0[r] = __builtin_amdgcn_exp2f(p0[r] - m_new); p1[r] = __builtin_amdgcn_exp2f(p1[r] - m_new); s_ += p0[r] + p1[r]; o0[r] *= alpha; o1[r] *= alpha; } \
        l_run = l_run * alpha + s_; \
        v4u w0, w1, w2, w3; \
        w0.x = cvtpk_rne(p0[0], p0[1]); w0.y = cvtpk_rne(p0[2], p0[3]); w0.z = cvtpk_rne(p0[4], p0[5]); w0.w = cvtpk_rne(p0[6], p0[7]); \
        w1.x = cvtpk_rne(p0[8], p0[9]); w1.y = cvtpk_rne(p0[10], p0[11]); w1.z = cvtpk_rne(p0[12], p0[13]); w1.w = cvtpk_rne(p0[14], p0[15]); \
        w2.x = cvtpk_rne(p1[0], p1[1]); w2.y = cvtpk_rne(p1[2], p1[3]); w2.z = cvtpk_rne(p1[4], p1[5]); w2.w = cvtpk_rne(p1[6], p1[7]); \
        w3.x = cvtpk_rne(p1[8], p1[9]); w3.y = cvtpk_rne(p1[10], p1[11]); w3.z = cvtpk_rne(p1[12], p1[13]); w3.w = cvtpk_rne(p1[14], p1[15]); \
        const bf16x8 pw0 = __builtin_bit_cast(bf16x8, w0), pw1 = __builtin_bit_cast(bf16x8, w1), pw2 = __builtin_bit_cast(bf16x8, w2), pw3 = __builtin_bit_cast(bf16x8, w3); \
        ATT_VFRAGS(VF); \
        o0 = __builtin_amdgcn_mfma_f32_32x32x16_bf16(VF[0][0], pw0, o0, 0, 0, 0); o1 = __builtin_amdgcn_mfma_f32_32x32x16_bf16(VF[0][1], pw0, o1, 0, 0, 0); \
        o0 = __builtin_amdgcn_mfma_f32_32x32x16_bf16(VF[1][0], pw1, o0, 0, 0, 0); o1 = __builtin_amdgcn_mfma_f32_32x32x16_bf16(VF[1][1], pw1, o1, 0, 0, 0); \
        o0 = __builtin_amdgcn_mfma_f32_32x32x16_bf16(VF[2][0], pw2, o0, 0, 0, 0); o1 = __builtin_amdgcn_mfma_f32_32x32x16_bf16(VF[2][1], pw2, o1, 0, 0, 0); \
        o0 = __builtin_amdgcn_mfma_f32_32x32x16_bf16(VF[3][0], pw3, o0, 0, 0, 0); o1 = __builtin_amdgcn_mfma_f32_32x32x16_bf16(VF[3][1], pw3, o1, 0, 0, 0); } while (0)
    bf16x8 kf0[4], kf1[4], vf[4][2]; v4u sk[8], sv[8];
    ATT_GLOADK(sk, t0); ATT_GLOADV(sv, t0); ATT_LWRITE(sk, 0); ATT_LWRITE(sv, 8192);
    for (int t = t0; t < 9; ++t) {
        const bool more = t + 1 < 9;
        if (more) ATT_GLOADK(sk, t + 1);
        ATT_COMPUTE(kf0, kf1, vf, t, more);
        if (more) { ATT_LWRITE(sk, 0); ATT_LWRITE(sv, 8192); }
    }
#undef ATT_GLOADK
#undef ATT_GLOADV
#undef ATT_LWRITE
#undef ATT_KFRAGS
#undef ATT_VFRAGS
#undef ATT_COMPUTE
    const float l = l_run + __shfl_xor(l_run, 32), inv = 1.0f / l;
    bf16* op = CAT + (size_t)tokq * 1024 + h * 64 + 4 * hi;
#pragma unroll
    for (int g4 = 0; g4 < 4; ++g4) {
        v2u a, bq; a.x = cvtpk_rne(o0[4 * g4] * inv, o0[4 * g4 + 1] * inv); a.y = cvtpk_rne(o0[4 * g4 + 2] * inv, o0[4 * g4 + 3] * inv);
        bq.x = cvtpk_rne(o1[4 * g4] * inv, o1[4 * g4 + 1] * inv); bq.y = cvtpk_rne(o1[4 * g4 + 2] * inv, o1[4 * g4 + 3] * inv);
        *(v2u*)(op + 8 * g4) = a; *(v2u*)(op + 32 + 8 * g4) = bq;
    }
}
__device__ __forceinline__ void attn_phase(Frame& F) {
    LAS float* tab = (LAS float*)F.lds;
    for (int i = F.tid; i < NH * NREL; i += NWAVES * 64) { const int h = i / NREL; tab[i] = (F.relb[i] - F.relb[h * NREL + 256]) * LOG2E; }
    __syncthreads();
    const int nslots = F.G * NWAVES;
    for (int it = F.vcu * NWAVES + F.wave; it < BATCH * NH * 64 * 2; it += nslots) {
        const int k = it >> 11, v = (it >> 3) & 255, w = it & 7;
        const int bh = v >> 2, sub = v & 3, c = k * 16 + sub * 4 + (w >> 1), half = w & 1;
        attn_item(F.QKU, F.VT, F.CAT, tab + (bh & 7) * NREL, F.lds + 8704 + F.wave * 16384, bh >> 3, c, bh & 7, half, F.lane);
    }
    __syncthreads();
}

__device__ __forceinline__ void final_norm(Frame& F) {
    const int gw = F.vcu * NWAVES + F.wave, NGW = F.G * NWAVES;
    f32x4 g[4];
#pragma unroll
    for (int j = 0; j < 4; ++j) g[j] = *(const f32x4*)(F.nf + (j >> 1) * 512 + 8 * F.lane + 4 * (j & 1));
    for (int m0 = 4 * gw; m0 < M; m0 += 4 * NGW) {
        v4u r[4][2]; float ri[4];
#pragma unroll
        for (int q = 0; q < 4; ++q) { const v4u* xr = (const v4u*)(F.XB + (size_t)(m0 + q) * D); r[q][0] = xr[F.lane]; r[q][1] = xr[64 + F.lane]; ri[q] = pg8::row_rinv(F.SS3, m0 + q); }
#pragma unroll
        for (int q = 0; q < 4; ++q) { float* orow = F.out + (size_t)(m0 + q) * D;
#pragma unroll
            for (int hh = 0; hh < 2; ++hh) { const v4u w = r[q][hh];
                const f32x4 a = (f32x4){__builtin_bit_cast(float, w.x << 16), __builtin_bit_cast(float, w.x & 0xffff0000u), __builtin_bit_cast(float, w.y << 16), __builtin_bit_cast(float, w.y & 0xffff0000u)};
                const f32x4 bq = (f32x4){__builtin_bit_cast(float, w.z << 16), __builtin_bit_cast(float, w.z & 0xffff0000u), __builtin_bit_cast(float, w.w << 16), __builtin_bit_cast(float, w.w & 0xffff0000u)};
                *(f32x4*)(orow + hh * 512 + 8 * F.lane) = a * ri[q] * g[2 * hh]; *(f32x4*)(orow + hh * 512 + 8 * F.lane + 4) = bq * ri[q] * g[2 * hh + 1]; } }
    }
}

struct Args { const float* in[18]; float* out; unsigned char* ws; int ph_lo, ph_hi; };
__global__ void __launch_bounds__(NWAVES * 64, 2) mk_fwd(Args args) {
    extern __shared__ __attribute__((aligned(16))) unsigned char lds[];
    Frame F;
    F.lds = (LAS unsigned char*)lds;
    F.tid = threadIdx.x; F.lane = F.tid & 63; F.wave = __builtin_amdgcn_readfirstlane(F.tid >> 6);
    F.G = gridDim.x; { const int bx = blockIdx.x; F.vcu = (F.G % 8 == 0) ? (bx % 8) * (F.G / 8) + bx / 8 : bx; }
    unsigned char* ws = args.ws;
    F.x = args.in[0]; F.n1 = args.in[1]; F.wg1 = args.in[2]; F.wu1 = args.in[3]; F.wd1 = args.in[4]; F.nm = args.in[5]; F.win = args.in[6]; F.qn = args.in[7]; F.kn = args.in[8];
    F.relb = args.in[9]; F.poolw = args.in[10]; F.pools = args.in[11]; F.wout = args.in[12]; F.n2 = args.in[13]; F.wg2 = args.in[14]; F.wu2 = args.in[15]; F.wd2 = args.in[16]; F.nf = args.in[17];
    F.out = args.out;
    F.SS0 = (float*)(ws + WS_SS0); F.SS1 = (float*)(ws + WS_SS1); F.SS2 = (float*)(ws + WS_SS2); F.SS3 = (float*)(ws + WS_SS3);
    F.Wgu1 = (bf16*)(ws + WS_WGU1); F.Wd1 = (bf16*)(ws + WS_WD1); F.Win = (bf16*)(ws + WS_WIN); F.Wv = (bf16*)(ws + WS_WV); F.Wout = (bf16*)(ws + WS_WOUT); F.Wgu2 = (bf16*)(ws + WS_WGU2); F.Wd2 = (bf16*)(ws + WS_WD2);
    F.XB = (bf16*)(ws + WS_XB); F.H = (bf16*)(ws + WS_H); F.QKU = (bf16*)(ws + WS_QKU); F.VT = (bf16*)(ws + WS_VT); F.CAT = (bf16*)(ws + WS_CAT);
    cg::grid_group grid = cg::this_grid();
    volatile LAS unsigned* bst = (volatile LAS unsigned*)(F.lds + LDS_BYTES - 64);
    if (F.tid < 2) bst[F.tid] = 0u;
    __syncthreads();
    XcdBarrier bar = xcd_barrier_post((unsigned*)ws, bst);
    const int lo = args.ph_lo, hi = args.ph_hi;
#define IN(k) (lo <= (k) && (k) < hi)
#define SEAM(k) do { if (IN(k) && IN((k) + 1)) { if (lo > 1000) grid.sync();   xcd_barrier(bar); } } while (0)
    const int bid = (int)blockIdx.x;

    if (IN(0)) { p0_prologue(F); SEAM(0); }
    if (IN(1)) {
        pg8::Gemm g{F.XB, F.Wgu1, M, 2 * FF, D}; pg8::StaticOrder S; S.init(M, 2 * FF, F.G, bid);
        pg8::EpiSwiGLU E{F.H, FF, F.SS0};
        pg8::gemm_phase<pg8::EpiSwiGLU, pg8::StaticOrder, true, true>(F.lds, g, S, E);
        SEAM(1);
    }
    if (IN(2)) {
        pg8::Gemm g{F.H, F.Wd1, M, D, FF}; pg8::StaticOrder S; S.init(M, D, F.G, bid);
        pg8::EpiRes<false> E{F.x, F.XB, F.SS1, 0.5f};
        pg8::gemm_phase<pg8::EpiRes<false>, pg8::StaticOrder, true, true>(F.lds, g, S, E);
        SEAM(2);
    }
    if (IN(3)) {
        { pg8::Gemm g{F.XB, F.Win, M, NPROJ, D}; pg8::StaticOrder S; S.init(M, NPROJ, F.G, bid);
          pg8::EpiProj E{F.QKU, F.SS1, F.qn, F.kn, 0.125f * LOG2E};
          pg8::gemm_phase<pg8::EpiProj, pg8::StaticOrder, true, true>(F.lds, g, S, E); }
        { pg8::Gemm g{F.Wv, F.XB, 512, M, D}; pg8::StaticOrder S; S.init(512, M, F.G, bid);
          pg8::EpiVT E{F.VT, M, F.SS1};
          pg8::gemm_phase<pg8::EpiVT, pg8::StaticOrder, true, true>(F.lds, g, S, E); }
        SEAM(3);
    }
    if (IN(4)) { pool_phase(F); attn_phase(F); SEAM(4); }
    if (IN(5)) {
        pg8::Gemm g{F.CAT, F.Wout, M, D, D}; pg8::StaticOrder S; S.init(M, D, F.G, bid);
        pg8::EpiRes<true> E{nullptr, F.XB, F.SS2, 1.0f};
        pg8::gemm_phase<pg8::EpiRes<true>, pg8::StaticOrder, true, true>(F.lds, g, S, E);
        SEAM(5);
    }
    if (IN(6)) {
        pg8::Gemm g{F.XB, F.Wgu2, M, 2 * FF, D}; pg8::StaticOrder S; S.init(M, 2 * FF, F.G, bid);
        pg8::EpiSwiGLU E{F.H, FF, F.SS2};
        pg8::gemm_phase<pg8::EpiSwiGLU, pg8::StaticOrder, true, true>(F.lds, g, S, E);
        SEAM(6);
    }
    if (IN(7)) {
        pg8::Gemm g{F.H, F.Wd2, M, D, FF}; pg8::StaticOrder S; S.init(M, D, F.G, bid);
        pg8::EpiRes<true> E{nullptr, F.XB, F.SS3, 0.5f};
        pg8::gemm_phase<pg8::EpiRes<true>, pg8::StaticOrder, true, true>(F.lds, g, S, E);
        SEAM(7);
    }
    if (IN(8)) final_norm(F);
#undef IN
#undef SEAM
}

extern "C" void kernel_launch(void* const* d_in, const int* in_sizes, int n_in, void* d_out, int out_size, void* d_ws, size_t ws_size, hipStream_t stream) {
    static int grid = 0;
    if (grid == 0) {
        if (n_in != 18 || in_sizes[0] != M * D || out_size != M * D || ws_size < WS_END) { fprintf(stderr, "kernel_launch: unexpected shapes (n_in %d, in0 %d, out %d, ws %zu); nothing launched\n", n_in, n_in > 0 ? in_sizes[0] : -1, out_size, ws_size); grid = -1; return; }
        int dev = 0, cus = 0, per_cu = 0;
        if (hipGetDevice(&dev) != hipSuccess || hipDeviceGetAttribute(&cus, hipDeviceAttributeMultiprocessorCount, dev) != hipSuccess) { grid = -1; return; }
        if (hipFuncSetAttribute((const void*)mk_fwd, hipFuncAttributeMaxDynamicSharedMemorySize, LDS_BYTES) != hipSuccess) { fprintf(stderr, "kernel_launch: hipFuncSetAttribute failed\n"); grid = -1; return; }
        if (hipOccupancyMaxActiveBlocksPerMultiprocessor(&per_cu, (const void*)mk_fwd, NWAVES * 64, LDS_BYTES) != hipSuccess || per_cu < 1) { fprintf(stderr, "kernel_launch: occupancy query says %d\n", per_cu); per_cu = 1; }
        (void)hipGetLastError();
        grid = cus * per_cu;
    }
    if (grid < 0) return;
    Args a{};
    for (int i = 0; i < 18; ++i) a.in[i] = (const float*)d_in[i];
    a.out = (float*)d_out; a.ws = (unsigned char*)d_ws;
    if (MK_N_LAUNCHES == 1) {
        if (hipMemsetAsync(d_ws, 0, 16384, stream) != hipSuccess) { fprintf(stderr, "kernel_launch: memset failed\n"); return; }
        a.ph_lo = 0; a.ph_hi = N_PHASES;
        void* kargs[] = {&a};
        const hipError_t e = hipLaunchCooperativeKernel((const void*)mk_fwd, dim3(grid), dim3(NWAVES * 64), kargs, LDS_BYTES, stream);
        if (e != hipSuccess) fprintf(stderr, "kernel_launch: cooperative launch failed: %s (grid %d)\n", hipGetErrorString(e), grid);
    } else {
        for (int p = 0; p < N_PHASES; ++p) { a.ph_lo = p; a.ph_hi = p + 1; hipLaunchKernelGGL(mk_fwd, dim3(grid), dim3(NWAVES * 64), LDS_BYTES, stream, a); }
    }
}
```

```cpp
#include <hip/hip_runtime.h>
#include <hip/hip_cooperative_groups.h>
#include <cstdio>
#include <cstdint>
#define MK_N_LAUNCHES 1
namespace pg8 {
#define PG8_LAS __attribute__((address_space(3)))
typedef unsigned short bf16_t;
typedef short bf16x8 __attribute__((ext_vector_type(8)));
typedef float f32x4 __attribute__((ext_vector_type(4)));
typedef unsigned u32x4 __attribute__((ext_vector_type(4)));
constexpr int BM = 256, BK = 64, HALF = 128, HTB = HALF * BK * 2  , STAGE_BYTES = 8 * HTB, NXCD = 8, WGM = 8;

__host__ __device__ __forceinline__ int lds_byte(int r, int c) { const int st = (r >> 4) * 2 + (c >> 5), rr = r & 15, cc = c & 31, ob = rr * 64 + cc * 2; return st * 1024 + (ob ^ (((ob >> 9) & 1) << 5)); }
__host__ __device__ __forceinline__ void stage_rc(int b, int& R, int& C) { const int st = b / 1024, sb = b % 1024, swz = sb ^ (((sb >> 9) & 1) << 5); R = (st >> 1) * 16 + swz / 64; C = (st & 1) * 32 + (swz % 64) / 2; }
__host__ __device__ __forceinline__ int perm32(int rho) { const int n = rho >> 4, i = rho & 15; return 8 * (i >> 2) + 4 * n + (i & 3); }

struct Unit { int pm, pn; };
struct Gemm { const bf16_t* A; const bf16_t* Bt; int M, N, K; };

struct StaticOrder {
    int nM, nN, nwg, G, c;
    __host__ __device__ void init(int M, int N, int G_, int c_) { nM = M / BM; nN = N / BM; nwg = nM * nN; G = G_; c = c_; }
    __host__ __device__ bool next(int i, Unit& u) const {
        const long L = (long)i * G + c; if (L >= nwg) return false;
        int wgid = (int)L; { const int q = nwg / NXCD, r = nwg % NXCD, xcd = wgid % NXCD, off = wgid / NXCD; wgid = (xcd < r ? xcd * (q + 1) : r * (q + 1) + (xcd - r) * q) + off; }
        const int nig = WGM * nN, gid = wgid / nig, fm = gid * WGM, gsz = (nM - fm) < WGM ? (nM - fm) : WGM;
        u.pm = fm + ((wgid % nig) % gsz); u.pn = (wgid % nig) / gsz; return true;
    }
    __device__ __forceinline__ void a_ready(const Unit&) const {}
    __device__ __forceinline__ void done(const Unit&) const {}
};

__device__ __forceinline__ unsigned cvt_pk_bf16(float lo, float hi) { unsigned r; asm volatile("v_cvt_pk_bf16_f32 %0, %1, %2" : "=v"(r) : "v"(lo), "v"(hi)); return r; }
typedef float f32x2 __attribute__((ext_vector_type(2)));
__device__ __forceinline__ float row_rinv(const float* ss, int row) {
    const f32x4* p = (const f32x4*)(ss + (size_t)row * 16);
    const f32x4 a = p[0], b = p[1], c = p[2], d = p[3];
    const float s = (((a[0] + a[1]) + (a[2] + a[3])) + ((b[0] + b[1]) + (b[2] + b[3]))) + (((c[0] + c[1]) + (c[2] + c[3])) + ((d[0] + d[1]) + (d[2] + d[3])));
    return __builtin_amdgcn_rsqf(s * (1.0f / 1024.0f) + 1e-6f);
}
__device__ __forceinline__ float silu_f(float x) { return x * __builtin_amdgcn_rcpf(1.0f + __builtin_amdgcn_exp2f(-1.4426950408889634f * x)); }

struct EpiSwiGLU {
    static constexpr bool PERM = true, AFTER_DRAIN = false;
    bf16_t* O; int ldc; const float* ss;
    __device__ __forceinline__ void operator()(const f32x4 (&acc)[2][2][4][2], const Unit& u, int wr, int wc, int fr, int fq) const {
        const int row0 = u.pm * BM + wr * 64 + fr, col0 = u.pn * 128 + wc * 32 + 8 * fq;
#pragma unroll
        for (int ai = 0; ai < 2; ++ai)
#pragma unroll
            for (int m = 0; m < 4; ++m) { const int row = row0 + ai * HALF + m * 16; const float ri = row_rinv(ss, row);
                const f32x4 g0 = acc[ai][0][m][0] * ri, g1 = acc[ai][0][m][1] * ri, u0 = acc[ai][1][m][0] * ri, u1 = acc[ai][1][m][1] * ri;
                float h[8];
#pragma unroll
                for (int j = 0; j < 4; ++j) { h[j] = silu_f(g0[j]) * u0[j]; h[4 + j] = silu_f(g1[j]) * u1[j]; }
                u32x4 w; w.x = cvt_pk_bf16(h[0], h[1]); w.y = cvt_pk_bf16(h[2], h[3]); w.z = cvt_pk_bf16(h[4], h[5]); w.w = cvt_pk_bf16(h[6], h[7]);
                *(u32x4*)(O + (size_t)row * ldc + col0) = w; }
    }
};

template <bool BASE_BF16> struct EpiRes {
    static constexpr bool PERM = true, AFTER_DRAIN = false;
    const float* base; bf16_t* xb; float* ss_out; float alpha;
    __device__ __forceinline__ void operator()(const f32x4 (&acc)[2][2][4][2], const Unit& u, int wr, int wc, int fr, int fq) const {
        const int row0 = u.pm * BM + wr * 64 + fr, col0 = u.pn * BM + wc * 32 + 8 * fq;
#pragma unroll
        for (int ai = 0; ai < 2; ++ai)
#pragma unroll
            for (int m = 0; m < 4; ++m) { const int row = row0 + ai * HALF + m * 16; float sq = 0.f;
#pragma unroll
                for (int bj = 0; bj < 2; ++bj) { const size_t off = (size_t)row * 1024 + col0 + bj * HALF;
                    f32x4 b0, b1;
                    if (BASE_BF16) { const u32x4 r = *(const u32x4*)(xb + off);
                        b0 = (f32x4){__builtin_bit_cast(float, r.x << 16), __builtin_bit_cast(float, r.x & 0xffff0000u), __builtin_bit_cast(float, r.y << 16), __builtin_bit_cast(float, r.y & 0xffff0000u)};
                        b1 = (f32x4){__builtin_bit_cast(float, r.z << 16), __builtin_bit_cast(float, r.z & 0xffff0000u), __builtin_bit_cast(float, r.w << 16), __builtin_bit_cast(float, r.w & 0xffff0000u)}; }
                    else { b0 = *(const f32x4*)(base + off); b1 = *(const f32x4*)(base + off + 4); }
                    const f32x4 v0 = b0 + acc[ai][bj][m][0] * alpha, v1 = b1 + acc[ai][bj][m][1] * alpha;
                    u32x4 w; w.x = cvt_pk_bf16(v0[0], v0[1]); w.y = cvt_pk_bf16(v0[2], v0[3]); w.z = cvt_pk_bf16(v1[0], v1[1]); w.w = cvt_pk_bf16(v1[2], v1[3]); *(u32x4*)(xb + off) = w;
                    sq += ((v0[0] * v0[0] + v0[1] * v0[1]) + (v0[2] * v0[2] + v0[3] * v0[3])) + ((v1[0] * v1[0] + v1[1] * v1[1]) + (v1[2] * v1[2] + v1[3] * v1[3])); }
                sq += __shfl_xor(sq, 16); sq += __shfl_xor(sq, 32);
                if (fq == 0) ss_out[(size_t)row * 16 + u.pn * 4 + wc] = sq; }
    }
};

struct EpiProj {
    static constexpr bool PERM = true, AFTER_DRAIN = false;
    bf16_t* O; const float* ss; const float* qg; const float* kg; float qscale;
    __device__ __forceinline__ void operator()(const f32x4 (&acc)[2][2][4][2], const Unit& u, int wr, int wc, int fr, int fq) const {
        const int row0 = u.pm * BM + wr * 64 + fr, col0 = u.pn * BM + wc * 64 + 8 * fq;
        const int kind = u.pn >> 1;
        float gn[2][8];
#pragma unroll
        for (int bj = 0; bj < 2; ++bj)
#pragma unroll
            for (int e = 0; e < 8; ++e) gn[bj][e] = 1.f;
        if (kind < 2) { const float* gp = kind == 0 ? qg : kg; const float sc = kind == 0 ? qscale : 1.f;
#pragma unroll
            for (int bj = 0; bj < 2; ++bj)
#pragma unroll
                for (int e = 0; e < 8; ++e) gn[bj][e] = gp[32 * bj + 8 * fq + e] * sc; }
#pragma unroll
        for (int ai = 0; ai < 2; ++ai)
#pragma unroll
            for (int m = 0; m < 4; ++m) { const int row = row0 + ai * HALF + m * 16; const float ri = row_rinv(ss, row);
                f32x4 v[2][2]; float sq = 0.f;
#pragma unroll
                for (int bj = 0; bj < 2; ++bj)
#pragma unroll
                    for (int n = 0; n < 2; ++n) { v[bj][n] = acc[ai][bj][m][n] * ri; const f32x4 t = v[bj][n]; sq += (t[0] * t[0] + t[1] * t[1]) + (t[2] * t[2] + t[3] * t[3]); }
                float hr = 1.f;
                if (kind < 2) { sq += __shfl_xor(sq, 16); sq += __shfl_xor(sq, 32); hr = __builtin_amdgcn_rsqf(sq * (1.0f / 64.0f) + 1e-6f); }
#pragma unroll
                for (int bj = 0; bj < 2; ++bj) { const f32x4 a = v[bj][0], b = v[bj][1]; u32x4 w;
                    w.x = cvt_pk_bf16(a[0] * hr * gn[bj][0], a[1] * hr * gn[bj][1]); w.y = cvt_pk_bf16(a[2] * hr * gn[bj][2], a[3] * hr * gn[bj][3]);
                    w.z = cvt_pk_bf16(b[0] * hr * gn[bj][4], b[1] * hr * gn[bj][5]); w.w = cvt_pk_bf16(b[2] * hr * gn[bj][6], b[3] * hr * gn[bj][7]);
                    *(u32x4*)(O + (size_t)row * 1536 + col0 + bj * 32) = w; } }
    }
};

struct EpiVT {
    static constexpr bool PERM = true, AFTER_DRAIN = false;
    bf16_t* O; int ldc; const float* ss;
    __device__ __forceinline__ void operator()(const f32x4 (&acc)[2][2][4][2], const Unit& u, int wr, int wc, int fr, int fq) const {
        const int row0 = u.pm * BM + wr * 64 + fr, col0 = u.pn * BM + wc * 32 + 8 * fq;
        float ri[2][8];
#pragma unroll
        for (int bj = 0; bj < 2; ++bj)
#pragma unroll
            for (int e = 0; e < 8; ++e) ri[bj][e] = row_rinv(ss, col0 + bj * HALF + e);
#pragma unroll
        for (int ai = 0; ai < 2; ++ai)
#pragma unroll
            for (int m = 0; m < 4; ++m) { const int row = row0 + ai * HALF + m * 16;
#pragma unroll
                for (int bj = 0; bj < 2; ++bj) { const f32x4 a = acc[ai][bj][m][0], b = acc[ai][bj][m][1]; u32x4 w;
                    w.x = cvt_pk_bf16(a[0] * ri[bj][0], a[1] * ri[bj][1]); w.y = cvt_pk_bf16(a[2] * ri[bj][2], a[3] * ri[bj][3]);
                    w.z = cvt_pk_bf16(b[0] * ri[bj][4], b[1] * ri[bj][5]); w.w = cvt_pk_bf16(b[2] * ri[bj][6], b[3] * ri[bj][7]);
                    *(u32x4*)(O + (size_t)row * ldc + col0 + bj * HALF) = w; } }
    }
};

template <class Epi, class Sched, bool ALIGN_EPI = false, bool SP2 = false>
__device__ __forceinline__ void gemm_phase(PG8_LAS unsigned char* lds, const Gemm g, const Sched& S, const Epi& E) {
    const int tid = threadIdx.x, wid = __builtin_amdgcn_readfirstlane(tid >> 6), lane = tid & 63, wr = wid >> 2, wc = wid & 3, fr = lane & 15, fq = lane >> 4;
    const int K = g.K, nt = K / BK;
    unsigned voffA[2], voffB[2];
#pragma unroll
    for (int i = 0; i < 2; ++i) { int R, C; stage_rc(tid * 16 + i * 8192, R, C); const int Rb = Epi::PERM ? ((R & ~31) + perm32(R & 31)) : R;
        voffA[i] = (unsigned)(R * K + C) * 2u; voffB[i] = (unsigned)(Rb * K + C) * 2u; }
    const size_t kstep = (size_t)(BK * 2);
    const size_t hstep = (size_t)HALF * K * 2;
    const size_t tstep = 2 * hstep;
    const unsigned ldsw = (unsigned)wid * 1024u;
    const int aoff = lds_byte(wr * 64 + fr, fq * 8), boff = lds_byte(wc * 32 + fr, fq * 8);
#define PG8_SA(b, h) (((b) * 2 + (h)) * HTB)
#define PG8_SB(b, h) ((4 + (b) * 2 + (h)) * HTB)
#define PG8_STAGE(bufoff, gbase, voff) do { _Pragma("unroll") for (int _i = 0; _i < 2; ++_i) \
        __builtin_amdgcn_global_load_lds((const unsigned*)((const char*)(gbase) + (voff)[_i]), (PG8_LAS unsigned*)(lds + (bufoff) + ldsw + _i * 8192), 16, 0, 0); } while (0)
#define PG8_LDA(dst, b, h) do { _Pragma("unroll") for (int m = 0; m < 4; ++m) _Pragma("unroll") for (int k = 0; k < 2; ++k) dst[m][k] = *(const PG8_LAS bf16x8*)(lds + PG8_SA(b, h) + aoff + m * 2048 + k * 1024); } while (0)
#define PG8_LDB(dst, b, h) do { _Pragma("unroll") for (int n = 0; n < 2; ++n) _Pragma("unroll") for (int k = 0; k < 2; ++k) dst[n][k] = *(const PG8_LAS bf16x8*)(lds + PG8_SB(b, h) + boff + n * 2048 + k * 1024); } while (0)
#define PG8_MMA(ai, bj, At, Bt) do { __builtin_amdgcn_s_setprio(1); _Pragma("unroll") for (int m = 0; m < 4; ++m) _Pragma("unroll") for (int n = 0; n < 2; ++n) _Pragma("unroll") for (int k = 0; k < 2; ++k) \
        acc[ai][bj][m][n] = __builtin_amdgcn_mfma_f32_16x16x32_bf16(Bt[n][k], At[m][k], acc[ai][bj][m][n], 0, 0, 0); __builtin_amdgcn_s_setprio(0); } while (0)
#define PG8_WAIT_V(n) asm volatile("s_waitcnt vmcnt(" #n ")" ::: "memory")
#define PG8_WAIT_L(n) asm volatile("s_waitcnt lgkmcnt(" #n ")" ::: "memory")
#define PG8_BAR __builtin_amdgcn_s_barrier()
#define PG8_SCHED __builtin_amdgcn_sched_barrier(0)
    Unit cur, nxt; int ui = 0;
    if (!S.next(0, cur)) return;
    f32x4 acc[2][2][4][2];
#pragma unroll
    for (int a = 0; a < 2; ++a)
#pragma unroll
        for (int b = 0; b < 2; ++b)
#pragma unroll
            for (int m = 0; m < 4; ++m)
#pragma unroll
                for (int n = 0; n < 2; ++n) acc[a][b][m][n] = (f32x4){0.f, 0.f, 0.f, 0.f};
    bf16x8 At[4][2], B0[2][2], B1[2][2];
    const char* cA = (const char*)g.A + (size_t)cur.pm * tstep; const char* cB = (const char*)g.Bt + (size_t)cur.pn * tstep;
    S.a_ready(cur);
    if constexpr (SP2) {
        PG8_STAGE(PG8_SB(0, 0), cB, voffB); PG8_STAGE(PG8_SB(0, 1), cB + hstep, voffB); PG8_STAGE(PG8_SA(0, 0), cA, voffA); PG8_STAGE(PG8_SA(0, 1), cA + hstep, voffA);
        if (wr == 1) PG8_BAR;
        PG8_WAIT_V(2); PG8_BAR;
        PG8_STAGE(PG8_SB(1, 0), cB + kstep, voffB); PG8_STAGE(PG8_SA(1, 0), cA + kstep, voffA); PG8_STAGE(PG8_SB(1, 1), cB + hstep + kstep, voffB);
        PG8_WAIT_V(6); PG8_BAR;
    } else {
        PG8_STAGE(PG8_SB(0, 0), cB, voffB); PG8_STAGE(PG8_SA(0, 0), cA, voffA); PG8_STAGE(PG8_SB(0, 1), cB + hstep, voffB); PG8_STAGE(PG8_SA(0, 1), cA + hstep, voffA);
        if (wr == 1) PG8_BAR;
        PG8_WAIT_V(4); PG8_BAR;
        PG8_STAGE(PG8_SB(1, 0), cB + kstep, voffB); PG8_STAGE(PG8_SA(1, 0), cA + kstep, voffA); PG8_STAGE(PG8_SB(1, 1), cB + hstep + kstep, voffB);
        PG8_WAIT_V(6); PG8_BAR;
    }
    for (;;) {
        const bool has_next = S.next(ui + 1, nxt);
        const char* nA = has_next ? (const char*)g.A + (size_t)nxt.pm * tstep : cA; const char* nB = has_next ? (const char*)g.Bt + (size_t)nxt.pn * tstep : cB;
        for (int t = 0; t < nt; t += 2) {
            const bool last = (t == nt - 2);
            const char* a1 = cA + (size_t)(t + 1) * kstep;
            const char* a2 = last ? nA : cA + (size_t)(t + 2) * kstep; const char* b2 = last ? nB : cB + (size_t)(t + 2) * kstep;
            const char* a3 = a2 + kstep; const char* b3 = b2 + kstep;
            if (last && has_next) S.a_ready(nxt);
            if constexpr (SP2) {
            PG8_LDB(B0, 0, 0); PG8_LDB(B1, 0, 1); PG8_SCHED; PG8_LDA(At, 0, 0); PG8_STAGE(PG8_SA(1, 1), a1 + hstep, voffA);
            PG8_WAIT_V(8); PG8_WAIT_L(0); PG8_BAR; PG8_MMA(0, 0, At, B0); PG8_MMA(0, 1, At, B1); PG8_BAR; PG8_SCHED;
            PG8_LDA(At, 0, 1); PG8_STAGE(PG8_SB(0, 0), b2, voffB); PG8_STAGE(PG8_SB(0, 1), b2 + hstep, voffB); PG8_STAGE(PG8_SA(0, 0), a2, voffA);
            PG8_WAIT_V(8); PG8_WAIT_L(0); PG8_BAR; PG8_MMA(1, 0, At, B0); PG8_MMA(1, 1, At, B1); PG8_BAR; PG8_SCHED;
            PG8_LDB(B0, 1, 0); PG8_LDB(B1, 1, 1); PG8_SCHED; PG8_LDA(At, 1, 0); PG8_STAGE(PG8_SA(0, 1), a2 + hstep, voffA);
            PG8_WAIT_V(8); PG8_WAIT_L(0); PG8_BAR; PG8_MMA(0, 0, At, B0); PG8_MMA(0, 1, At, B1); PG8_BAR; PG8_SCHED;
            PG8_LDA(At, 1, 1); PG8_STAGE(PG8_SB(1, 0), b3, voffB); PG8_STAGE(PG8_SB(1, 1), b3 + hstep, voffB); PG8_STAGE(PG8_SA(1, 0), a3, voffA);
            PG8_WAIT_V(8); PG8_WAIT_L(0); PG8_BAR; PG8_MMA(1, 0, At, B0); PG8_MMA(1, 1, At, B1); PG8_BAR; PG8_SCHED;
            } else {
            PG8_LDB(B0, 0, 0); PG8_SCHED; PG8_LDA(At, 0, 0); PG8_STAGE(PG8_SA(1, 1), a1 + hstep, voffA);
            PG8_WAIT_L(8); PG8_BAR; PG8_WAIT_L(0); PG8_MMA(0, 0, At, B0); PG8_BAR; PG8_SCHED;
            PG8_LDB(B1, 0, 1); PG8_STAGE(PG8_SB(0, 0), b2, voffB);
            PG8_BAR; PG8_WAIT_L(0); PG8_MMA(0, 1, At, B1); PG8_BAR;
            PG8_LDA(At, 0, 1); PG8_STAGE(PG8_SA(0, 0), a2, voffA);
            PG8_BAR; PG8_WAIT_L(0); PG8_MMA(1, 0, At, B0); PG8_BAR; PG8_SCHED;
            PG8_STAGE(PG8_SB(0, 1), b2 + hstep, voffB);
            PG8_WAIT_V(6); PG8_BAR; PG8_MMA(1, 1, At, B1); PG8_BAR;
            PG8_LDB(B0, 1, 0); PG8_SCHED; PG8_LDA(At, 1, 0); PG8_STAGE(PG8_SA(0, 1), a2 + hstep, voffA);
            PG8_WAIT_L(8); PG8_BAR; PG8_WAIT_L(0); PG8_MMA(0, 0, At, B0); PG8_BAR; PG8_SCHED;
            PG8_LDB(B1, 1, 1); PG8_STAGE(PG8_SB(1, 0), b3, voffB);
            PG8_BAR; PG8_WAIT_L(0); PG8_MMA(0, 1, At, B1); PG8_BAR;
            PG8_LDA(At, 1, 1); PG8_STAGE(PG8_SA(1, 0), a3, voffA);
            PG8_BAR; PG8_WAIT_L(0); PG8_MMA(1, 0, At, B0); PG8_BAR; PG8_SCHED;
            PG8_STAGE(PG8_SB(1, 1), b3 + hstep, voffB);
            PG8_WAIT_V(6); PG8_BAR; PG8_MMA(1, 1, At, B1); PG8_BAR;
            }
        }
        if constexpr (ALIGN_EPI) { if (wr == 0) PG8_BAR; }
        if constexpr (!Epi::AFTER_DRAIN) { E(acc, cur, wr, wc, fr, fq); S.done(cur); }
        if (!has_next) break;
#pragma unroll
        for (int a = 0; a < 2; ++a)
#pragma unroll
            for (int b = 0; b < 2; ++b)
#pragma unroll
                for (int m = 0; m < 4; ++m)
#pragma unroll
                    for (int n = 0; n < 2; ++n) acc[a][b][m][n] = (f32x4){0.f, 0.f, 0.f, 0.f};
        cur = nxt; cA = nA; cB = nB; ++ui;
        if constexpr (ALIGN_EPI) { if (wr == 1) PG8_BAR; }
    }
    PG8_WAIT_V(0);
    if constexpr (!ALIGN_EPI) { if (wr == 0) PG8_BAR; }
    PG8_BAR;
    if constexpr (Epi::AFTER_DRAIN) { E.fused(acc, cur, wr, wc, fr, fq, lds, wid, lane); S.done(cur); }
#undef PG8_SA
#undef PG8_SB
#undef PG8_STAGE
#undef PG8_LDA
#undef PG8_LDB
#undef PG8_MMA
#undef PG8_WAIT_V
#undef PG8_WAIT_L
#undef PG8_BAR
#undef PG8_SCHED
}
}

namespace cg = cooperative_groups;
#define GAS __attribute__((address_space(1)))
#define LAS __attribute__((address_space(3)))
typedef unsigned short bf16;
typedef unsigned v4u __attribute__((ext_vector_type(4)));
typedef unsigned v2u __attribute__((ext_vector_type(2)));
typedef float f32x4 __attribute__((ext_vector_type(4)));
typedef short bf16x8 __attribute__((ext_vector_type(8)));
typedef float f32x16 __attribute__((ext_vector_type(16)));

constexpr int NWAVES = 8;
constexpr int BATCH = 8, SEQ = 4096, D = 1024, FF = 2816, DA = 512, HD = 64, NH = 8, DP = 512, NREL = 257;
constexpr int M = BATCH * SEQ;
constexpr int NPROJ = 1536;
constexpr float LOG2E = 1.4426950408889634f;
#ifndef MK_N_LAUNCHES
#define MK_N_LAUNCHES 1
#endif
constexpr int N_PHASES = 9;

constexpr size_t MiB = 1u << 20;
constexpr size_t WS_SS0 = 2 * MiB, WS_SS1 = 4 * MiB, WS_SS2 = 6 * MiB, WS_SS3 = 8 * MiB;
constexpr size_t WS_WGU1 = 10 * MiB, WS_WD1 = 21 * MiB, WS_WIN = 27 * MiB, WS_WV = 30 * MiB, WS_WOUT = 31 * MiB, WS_WGU2 = 33 * MiB, WS_WD2 = 44 * MiB;
constexpr size_t WS_XB = 50 * MiB;
constexpr size_t WS_H = 114 * MiB;
constexpr size_t WS_QKU = 114 * MiB, WS_VT = 210 * MiB, WS_CAT = 242 * MiB, WS_END = 306 * MiB;
static_assert(WS_H + (size_t)M * FF * 2 <= WS_END && WS_QKU + (size_t)M * NPROJ * 2 <= WS_VT && WS_VT + (size_t)512 * M * 2 <= WS_CAT && WS_CAT + (size_t)M * 1024 * 2 <= WS_END, "ws map");

constexpr int STAGE_LDS = 131072, LDS_BYTES = 143360;

#define LDS_WAIT() asm volatile("s_waitcnt lgkmcnt(0)" ::: "memory")
__device__ __forceinline__ unsigned f2bf(float f) { unsigned u = __builtin_bit_cast(unsigned, f); return (u + 0x7fffu + ((u >> 16) & 1u)) >> 16; }
__device__ __forceinline__ unsigned pk2(float lo, float hi) { return f2bf(lo) | (f2bf(hi) << 16); }
__device__ __forceinline__ float bf2f(unsigned short b) { return __builtin_bit_cast(float, (unsigned)b << 16); }
__device__ __forceinline__ float wave_sum(float v) {
#pragma unroll
    for (int o = 1; o < 64; o <<= 1) v += __shfl_xor(v, o);
    return v;
}

#define XB_TMO      128
#define XB_XCNT(j)  (256  + 64 * (j))
#define XB_XSUB(j)  (1280 + 64 * (j))
#define XB_XGEN(j)  (2304 + 64 * (j))
#define XB_TOP      3328
#define XB_TOPGEN   3392
#define XCD_BAR_WORDS 3456
#define XB_SPIN_CAP (1u << 18)

__device__ __forceinline__ unsigned xb_ld(unsigned* p)              { return __hip_atomic_load(p, __ATOMIC_RELAXED, __HIP_MEMORY_SCOPE_AGENT); }
__device__ __forceinline__ unsigned xb_add(unsigned* p, unsigned v) { return __hip_atomic_fetch_add(p, v, __ATOMIC_RELAXED, __HIP_MEMORY_SCOPE_AGENT); }
__device__ __forceinline__ unsigned xb_xcc_id() { return (unsigned)__builtin_amdgcn_s_getreg((3 << 11) | 20) & 0xFu; }
#define XB_SPIN(cond, bar) do { unsigned _sp = 0; while (cond) { __builtin_amdgcn_s_sleep(1); \
    if ((++_sp & 255u) == 0u) { if (xb_ld(&(bar)[XB_TMO])) break; if (_sp > XB_SPIN_CAP) { atomicAdd(&(bar)[XB_TMO], 1u); break; } } } } while (0)

struct XcdBarrier {
    unsigned* bar; unsigned x;
    volatile LAS unsigned* st;
};

__device__ __forceinline__ XcdBarrier xcd_barrier_post(unsigned* bar, volatile LAS unsigned* st) {
    XcdBarrier b; b.bar = bar; b.x = xb_xcc_id(); b.st = st;
    if (threadIdx.x == 0) (void)xb_add(&bar[XB_XCNT(b.x)], 1u);
    return b;
}
__device__ __forceinline__ void xcd_barrier_complete(unsigned* bar, unsigned x, unsigned& nloc, unsigned& nx) {
    const unsigned G = gridDim.x * gridDim.y * gridDim.z;
    unsigned sum, cnt, mine, sp = 0u;
    for (;;) {
        sum = 0u; cnt = 0u; mine = 0u;
#pragma unroll
        for (unsigned j = 0; j < 16; ++j) { const unsigned c = xb_ld(&bar[XB_XCNT(j)]); sum += c; cnt += (c > 0u) ? 1u : 0u; mine = (j == x) ? c : mine; }
        if (sum == G) break;
        __builtin_amdgcn_s_sleep(1);
        if ((++sp & 255u) == 0u) { if (xb_ld(&bar[XB_TMO])) break; if (sp > XB_SPIN_CAP) { atomicAdd(&bar[XB_TMO], 1u); break; } }
    }
    nloc = mine > 0u ? mine : 1u; nx = cnt > 0u ? cnt : 1u;
}

__device__ __forceinline__ void xcd_barrier(const XcdBarrier& b) {
    asm volatile("s_waitcnt vmcnt(0)" ::: "memory");
    __syncthreads();
    if (threadIdx.x == 0) {
        unsigned* bar = b.bar;
        __builtin_amdgcn_s_waitcnt(0);
        unsigned nloc = b.st[0], nx = b.st[1];
        if (nloc == 0u) { xcd_barrier_complete(bar, b.x, nloc, nx); b.st[0] = nloc; b.st[1] = nx; }
        const unsigned old = xb_add(&bar[XB_XSUB(b.x)], 1u);
        const unsigned gen = old / nloc;
        if (old + 1u == (gen + 1u) * nloc) {
            __builtin_amdgcn_fence(__ATOMIC_RELEASE, "agent");
            asm volatile("s_waitcnt vmcnt(0)" ::: "memory");
            const unsigned og = xb_add(&bar[XB_TOP], 1u);
            const unsigned tg = og / nx;
            if (og + 1u == (tg + 1u) * nx) xb_add(&bar[XB_TOPGEN], 1u);
            else XB_SPIN(xb_ld(&bar[XB_TOPGEN]) == tg, bar);
            __builtin_amdgcn_fence(__ATOMIC_ACQUIRE, "agent");
            xb_add(&bar[XB_XGEN(b.x)], 1u);
            asm volatile("s_waitcnt vmcnt(0)" ::: "memory");
        } else {
            XB_SPIN(xb_ld(&bar[XB_XGEN(b.x)]) == gen, bar);
            __builtin_amdgcn_fence(__ATOMIC_ACQUIRE, "agent");
            asm volatile("s_waitcnt vmcnt(0)" ::: "memory");
        }
    }
    __syncthreads();
}

struct Frame {
    LAS unsigned char* lds;
    int tid, lane, wave, vcu, G;
    const float *x, *n1, *wg1, *wu1, *wd1, *nm, *win, *qn, *kn, *relb, *poolw, *pools, *wout, *n2, *wg2, *wu2, *wd2, *nf;
    float* out;
    float *SS0, *SS1, *SS2, *SS3;
    bf16 *Wgu1, *Wd1, *Win, *Wv, *Wout, *Wgu2, *Wd2, *XB, *H, *QKU, *VT, *CAT;
};

__device__ __forceinline__ void transpose_item(const float* W, int Nsrc, int k0, int srccol0, const float* gain, bf16* WT, int Kdst, int dstrow0, LAS float* scr, int lane) {
#pragma unroll
    for (int i = 0; i < 32; ++i) { const int kk = 2 * i + (lane >> 5); const float g = gain ? gain[k0 + kk] : 1.f; scr[kk * 33 + (lane & 31)] = W[(size_t)(k0 + kk) * Nsrc + srccol0 + (lane & 31)] * g; }
    LDS_WAIT(); asm volatile("" ::: "memory");
    const int c = lane & 7;
#pragma unroll
    for (int j = 0; j < 4; ++j) { const int n = (lane >> 3) + 8 * j; const LAS float* s = scr + (8 * c) * 33 + n;
        v4u o; o.x = pk2(s[0 * 33], s[1 * 33]); o.y = pk2(s[2 * 33], s[3 * 33]); o.z = pk2(s[4 * 33], s[5 * 33]); o.w = pk2(s[6 * 33], s[7 * 33]);
        *(v4u*)(WT + (size_t)(dstrow0 + n) * Kdst + k0 + 8 * c) = o; }
    LDS_WAIT(); asm volatile("" ::: "memory");
}
__device__ __forceinline__ void gu_item(const float* wg, const float* wu, const float* gain, bf16* WT, int item, LAS float* scr, int lane) {
    const int nblk = (2 * FF) / 32, kb = item / nblk, nb = item % nblk, n0 = 32 * nb;
    const int pn = n0 >> 8, bj = (n0 >> 7) & 1, i0 = n0 & 127;
    transpose_item(bj ? wu : wg, FF, 64 * kb, 128 * pn + i0, gain, WT, D, n0, scr, lane);
}
__device__ __forceinline__ void plain_item(const float* W, int K, int N, int srccol_off, int Nsrc, const float* gain, bf16* WT, int item, LAS float* scr, int lane) {
    const int nblk = N / 32, kb = item / nblk, nb = item % nblk;
    transpose_item(W, Nsrc, 64 * kb, srccol_off + 32 * nb, gain, WT, K, 32 * nb, scr, lane);
}
__device__ __forceinline__ void qk_item(const float* win, const float* gain, bf16* WT, int item, LAS float* scr, int lane) {
    const int nblk = 1024 / 32, kb = item / nblk, nb = item % nblk, n0 = 32 * nb;
    const int pn = n0 >> 8, bj = (n0 >> 7) & 1, wc = (n0 >> 5) & 3;
    transpose_item(win, 2048, 64 * kb, 256 * pn + 64 * wc + 32 * bj, gain, WT, D, n0, scr, lane);
}

__device__ __forceinline__ void p0_prologue(Frame& F) {
    {
        const int xw = F.vcu * NWAVES + F.wave, NXW = F.G * NWAVES;
        for (int m = 4 * xw; m < M; m += 4 * NXW) {
            const f32x4* xr = (const f32x4*)(F.x + (size_t)m * D) + F.lane; f32x4 v[16]; float s[4] = {0.f, 0.f, 0.f, 0.f};
#pragma unroll
            for (int j = 0; j < 16; ++j) v[j] = xr[64 * j];
#pragma unroll
            for (int j = 0; j < 16; ++j) s[j >> 2] += (v[j][0] * v[j][0] + v[j][1] * v[j][1]) + (v[j][2] * v[j][2] + v[j][3] * v[j][3]);
#pragma unroll
            for (int r = 0; r < 4; ++r) s[r] = wave_sum(s[r]);
            v2u* o8 = (v2u*)(F.XB + (size_t)m * D) + F.lane;
#pragma unroll
            for (int j = 0; j < 16; ++j) { v2u w; w.x = pk2(v[j][0], v[j][1]); w.y = pk2(v[j][2], v[j][3]); o8[64 * j] = w; }
            const int r = F.lane >> 4; const float sv = r == 0 ? s[0] : (r == 1 ? s[1] : (r == 2 ? s[2] : s[3]));
            F.SS0[(size_t)m * 16 + F.lane] = (F.lane & 15) == 0 ? sv : 0.f;
        }
    }
    LAS float* scr = (LAS float*)(F.lds + F.wave * 16384);
    const int gw = F.vcu * NWAVES + F.wave, NGW = F.G * NWAVES;
    constexpr int I_GU = (D / 64) * (2 * FF / 32), I_D = (FF / 64) * (D / 32), I_QK = (D / 64) * (1024 / 32), I_V = (D / 64) * (512 / 32), I_O = (D / 64) * (D / 32);
    constexpr int NITEMS = 2 * I_GU + 2 * I_D + I_QK + I_V + I_O;
    for (int it = gw; it < (D / 4) * 8; it += NGW) {
        const int k0 = (it >> 3) * 4, cb = it & 7, ucol = cb * 64 + F.lane, g = cb >> 1, d = ucol & 127;
        const float* wrow = F.win + (size_t)k0 * 2048 + 1536 + g * 128; const float* pw = F.poolw + (size_t)g * 128 * 128 + d;
        float a0 = 0.f, a1 = 0.f, a2 = 0.f, a3 = 0.f;
#pragma unroll 16
        for (int c = 0; c < 128; ++c) { const float p = pw[(size_t)c * 128]; a0 += wrow[c] * p; a1 += wrow[2048 + c] * p; a2 += wrow[4096 + c] * p; a3 += wrow[6144 + c] * p; }
        const float ps = F.pools[ucol];
        const int t = ucol >> 8, wc = (ucol >> 6) & 3, bj = (ucol >> 5) & 1, i = ucol & 31;
        v2u w; w.x = pk2(a0 * ps * F.nm[k0], a1 * ps * F.nm[k0 + 1]); w.y = pk2(a2 * ps * F.nm[k0 + 2], a3 * ps * F.nm[k0 + 3]);
        *(v2u*)(F.Win + (size_t)(1024 + 256 * t + 128 * bj + 32 * wc + i) * D + k0) = w;
    }
    for (int it = gw; it < NITEMS; it += NGW) {
        int r = it;
        if (r < I_GU) { gu_item(F.wg1, F.wu1, F.n1, F.Wgu1, r, scr, F.lane); continue; } r -= I_GU;
        if (r < I_GU) { gu_item(F.wg2, F.wu2, F.n2, F.Wgu2, r, scr, F.lane); continue; } r -= I_GU;
        if (r < I_D) { plain_item(F.wd1, FF, D, 0, D, nullptr, F.Wd1, r, scr, F.lane); continue; } r -= I_D;
        if (r < I_D) { plain_item(F.wd2, FF, D, 0, D, nullptr, F.Wd2, r, scr, F.lane); continue; } r -= I_D;
        if (r < I_QK) { qk_item(F.win, F.nm, F.Win, r, scr, F.lane); continue; } r -= I_QK;
        if (r < I_V) { plain_item(F.win, D, 512, 1024, 2048, F.nm, F.Wv, r, scr, F.lane); continue; } r -= I_V;
        plain_item(F.wout, D, D, 0, D, nullptr, F.Wout, r, scr, F.lane);
    }
}

__device__ __forceinline__ void pool_phase(Frame& F) {
    const int gt = F.vcu * (NWAVES * 64) + F.tid, NT = F.G * NWAVES * 64;
    for (int it = gt; it < M * 64; it += NT) {
        const int tok = it >> 6, cgp = it & 63, s = tok & (SEQ - 1), g = cgp >> 4, w = 2 << g;
        const int n = (s + 1 < w) ? s + 1 : w;
        const bf16* up = F.QKU + (size_t)tok * NPROJ + 1024 + cgp * 8;
        float acc[8], cur[8];
        { const bf16x8 v = *(const bf16x8*)up;
#pragma unroll
          for (int e = 0; e < 8; ++e) { cur[e] = bf2f((unsigned short)v[e]); acc[e] = cur[e]; } }
        for (int j = 1; j < n; ++j) { const bf16x8 v = *(const bf16x8*)(up - (size_t)j * NPROJ);
#pragma unroll
            for (int e = 0; e < 8; ++e) acc[e] += bf2f((unsigned short)v[e]); }
        const float inv = 1.0f / (float)n;
        v4u o; o.x = pk2(acc[0] * inv - cur[0], acc[1] * inv - cur[1]); o.y = pk2(acc[2] * inv - cur[2], acc[3] * inv - cur[3]);
        o.z = pk2(acc[4] * inv - cur[4], acc[5] * inv - cur[5]); o.w = pk2(acc[6] * inv - cur[6], acc[7] * inv - cur[7]);
        *(v4u*)(F.CAT + (size_t)tok * 1024 + 512 + cgp * 8) = o;
    }
}

__device__ __forceinline__ unsigned cvtpk_rne(float lo, float hi) { unsigned r; asm volatile("v_cvt_pk_bf16_f32 %0, %1, %2" : "=v"(r) : "v"(lo), "v"(hi)); return r; }
__device__ __forceinline__ void attn_item(const bf16* QKU, const bf16* VT, bf16* CAT, const LAS float* btab, LAS unsigned char* wl, int b, int c, int h, int half, int lane) {
    const int r32 = lane & 31, hi = lane >> 5;
    const int qi = half * 32 + r32, tokq = b * SEQ + c * 64 + qi;
    bf16x8 qf[4];
    { const bf16* qp = QKU + (size_t)tokq * NPROJ + h * 64 + hi * 8;
#pragma unroll
      for (int d0 = 0; d0 < 4; ++d0) qf[d0] = *(const bf16x8*)(qp + d0 * 16); }
    const int pi = (r32 & 16) + 8 * ((r32 >> 2) & 1) + (r32 & 3) + 4 * ((r32 >> 3) & 1);
    float m_run = -1e30f, l_run = 0.f; f32x16 o0 = {}, o1 = {};
    const int t0 = c >= 8 ? 0 : 8 - c;
    const int lrow = lane >> 3, lch = lane & 7;
    const bf16* kg = QKU + (size_t)(b * SEQ + (c - 8) * 64 + lrow) * NPROJ + 512 + h * 64 + lch * 8;
    const bf16* vg = VT + (size_t)(h * 64 + lrow) * M + b * SEQ + (c - 8) * 64 + lch * 8;
    const int wofs = lrow * 128 + ((lch ^ lrow) << 4);
    const int kofs = pi * 128, ksw = pi & 7, vofs = 8192 + r32 * 128, vsw = r32 & 7;
#define ATT_GLOADK(SK, t) do { const bf16* kp_ = kg + (size_t)(t) * 64 * NPROJ; _Pragma("unroll") for (int i = 0; i < 8; ++i) SK[i] = *(const v4u*)(kp_ + (size_t)i * 8 * NPROJ); } while (0)
#define ATT_GLOADV(SV, t) do { const bf16* vp_ = vg + (t) * 64; _Pragma("unroll") for (int i = 0; i < 8; ++i) SV[i] = *(const v4u*)(vp_ + (size_t)i * 8 * M); } while (0)
#define ATT_LWRITE(S, base) do { _Pragma("unroll") for (int i = 0; i < 8; ++i) *(LAS v4u*)(wl + (base) + wofs + i * 1024) = S[i]; } while (0)
#define ATT_KFRAGS(KF0, KF1) do { _Pragma("unroll") for (int d0 = 0; d0 < 4; ++d0) { KF0[d0] = *(const LAS bf16x8*)(wl + kofs + (((2 * d0 + hi) ^ ksw) << 4)); KF1[d0] = *(const LAS bf16x8*)(wl + 4096 + kofs + (((2 * d0 + hi) ^ ksw) << 4)); } } while (0)
#define ATT_VFRAGS(VF) do { _Pragma("unroll") for (int ks = 0; ks < 4; ++ks) { VF[ks][0] = *(const LAS bf16x8*)(wl + vofs + (((2 * ks + hi) ^ vsw) << 4)); VF[ks][1] = *(const LAS bf16x8*)(wl + 4096 + vofs + (((2 * ks + hi) ^ vsw) << 4)); } } while (0)
#define ATT_COMPUTE(KF0, KF1, VF, t, MORE) do { \
        f32x16 p0 = {}, p1 = {}; \
        ATT_KFRAGS(KF0, KF1); \
        _Pragma("unroll") for (int d0 = 0; d0 < 4; ++d0) { p0 = __builtin_amdgcn_mfma_f32_32x32x16_bf16(KF0[d0], qf[d0], p0, 0, 0, 0); p1 = __builtin_amdgcn_mfma_f32_32x32x16_bf16(KF1[d0], qf[d0], p1, 0, 0, 0); } \
        if (MORE) ATT_GLOADV(sv, (t) + 1); \
        if ((t) >= 6) { const int base_ = 512 - 64 * (t) + qi - 8 * hi + 128; \
            _Pragma("unroll") for (int r = 0; r < 16; ++r) { const int off_ = 16 * (r >> 3) + (r & 7); int i0 = base_ - off_, i1 = base_ - 32 - off_; i0 = i0 > 256 ? 256 : i0; i1 = i1 > 256 ? 256 : i1; \
                p0[r] += btab[i0]; p1[r] += btab[i1]; } } \
        float mx = fmaxf(p0[0], p1[0]); \
        _Pragma("unroll") for (int r = 1; r < 16; ++r) mx = fmaxf(mx, fmaxf(p0[r], p1[r])); \
        mx = fmaxf(mx, __shfl_xor(mx, 32)); \
        const float m_new = fmaxf(m_run, mx), alpha = __builtin_amdgcn_exp2f(m_run - m_new); m_run = m_new; \
        float s_ = 0.f; \
        _Pragma("unroll") for (int r = 0; r < 16; ++r) { p0[r] = __builtin_amdgcn_exp2f(p0[r] - m_new); p1[r] = __builtin_amdgcn_exp2f(p1[r] - m_new); s_ += p0[r] + p1[r]; o0[r] *= alpha; o1[r] *= alpha; } \
        l_run = l_run * alpha + s_; \
        v4u w0, w1, w2, w3; \
        w0.x = cvtpk_rne(p0[0], p0[1]); w0.y = cvtpk_rne(p0[2], p0[3]); w0.z = cvtpk_rne(p0[4], p0[5]); w0.w = cvtpk_rne(p0[6], p0[7]); \
        w1.x = cvtpk_rne(p0[8], p0[9]); w1.y = cvtpk_rne(p0[10], p0[11]); w1.z = cvtpk_rne(p0[12], p0[13]); w1.w = cvtpk_rne(p0[14], p0[15]); \
        w2.x = cvtpk_rne(p1[0], p1[1]); w2.y = cvtpk_rne(p1[2], p1[3]); w2.z = cvtpk_rne(p1[4], p1[5]); w2.w = cvtpk_rne(p1[6], p1[7]); \
        w3.x = cvtpk_rne(p1[8], p1[9]); w3.y = cvtpk_rne(p1[10], p1[11]); w3.z = cvtpk_rne(p1[12], p1[13]); w3.w = cvtpk_rne(p1[14], p1[15]); \
        const bf16x8 pw0 = __builtin_bit_cast(bf16x8, w0), pw1 = __builtin_bit_cast(bf16x8, w1), pw2 = __builtin_bit_cast(bf16x8, w2), pw3 = __builtin_bit_cast(bf16x8, w3); \
        ATT_VFRAGS(VF); \
        o0 = __builtin_amdgcn_mfma_f32_32x32x16_bf16(VF[0][0], pw0, o0, 0, 0, 0); o1 = __builtin_amdgcn_mfma_f32_32x32x16_bf16(VF[0][1], pw0, o1, 0, 0, 0); \
        o0 = __builtin_amdgcn_mfma_f32_32x32x16_bf16(VF[1][0], pw1, o0, 0, 0, 0); o1 = __builtin_amdgcn_mfma_f32_32x32x16_bf16(VF[1][1], pw1, o1, 0, 0, 0); \
        o0 = __builtin_amdgcn_mfma_f32_32x32x16_bf16(VF[2][0], pw2, o0, 0, 0, 0); o1 = __builtin_amdgcn_mfma_f32_32x32x16_bf16(VF[2][1], pw2, o1, 0, 0, 0); \
        o0 = __builtin_amdgcn_mfma_f32_32x32x16_bf16(VF[3][0], pw3, o0, 0, 0, 0); o1 = __builtin_amdgcn_mfma_f32_32x32x16_bf16(VF[3][1], pw3, o1, 0, 0, 0); } while (0)
    bf16x8 kf0[4], kf1[4], vf[4][2]; v4u sk[8], sv[8];
    ATT_GLOADK(sk, t0); ATT_GLOADV(sv, t0); ATT_LWRITE(sk, 0); ATT_LWRITE(sv, 8192);
    for (int t = t0; t < 9; ++t) {
        const bool more = t + 1 < 9;
        if (more) ATT_GLOADK(sk, t + 1);
        ATT_COMPUTE(kf0, kf1, vf, t, more);
        if (more) { ATT_LWRITE(sk, 0); ATT_LWRITE(sv, 8192); }
    }
#undef ATT_GLOADK
#undef ATT_GLOADV
#undef ATT_LWRITE
#undef ATT_KFRAGS
#undef ATT_VFRAGS
#undef ATT_COMPUTE
    const float l = l_run + __shfl_xor(l_run, 32), inv = 1.0f / l;
    bf16* op = CAT + (size_t)tokq * 1024 + h * 64 + 4 * hi;
#pragma unroll
    for (int g4 = 0; g4 < 4; ++g4) {
        v2u a, bq; a.x = cvtpk_rne(o0[4 * g4] * inv, o0[4 * g4 + 1] * inv); a.y = cvtpk_rne(o0[4 * g4 + 2] * inv, o0[4 * g4 + 3] * inv);
        bq.x = cvtpk_rne(o1[4 * g4] * inv, o1[4 * g4 + 1] * inv); bq.y = cvtpk_rne(o1[4 * g4 + 2] * inv, o1[4 * g4 + 3] * inv);
        *(v2u*)(op + 8 * g4) = a; *(v2u*)(op + 32 + 8 * g4) = bq;
    }
}
__device__ __forceinline__ void attn_phase(Frame& F) {
    LAS float* tab = (LAS float*)F.lds;
    for (int i = F.tid; i < NH * NREL; i += NWAVES * 64) { const int h = i / NREL; tab[i] = (F.relb[i] - F.relb[h * NREL + 256]) * LOG2E; }
    __syncthreads();
    const int nslots = F.G * NWAVES;
    for (int it = F.vcu * NWAVES + F.wave; it < BATCH * NH * 64 * 2; it += nslots) {
        const int k = it >> 11, v = (it >> 3) & 255, w = it & 7;
        const int bh = v >> 2, sub = v & 3, c = k * 16 + sub * 4 + (w >> 1), half = w & 1;
        attn_item(F.QKU, F.VT, F.CAT, tab + (bh & 7) * NREL, F.lds + 8704 + F.wave * 16384, bh >> 3, c, bh & 7, half, F.lane);
    }
    __syncthreads();
}

__device__ __forceinline__ void final_norm(Frame& F) {
    const int gw = F.vcu * NWAVES + F.wave, NGW = F.G * NWAVES;
    f32x4 g[4];
#pragma unroll
    for (int j = 0; j < 4; ++j) g[j] = *(const f32x4*)(F.nf + (j >> 1) * 512 + 8 * F.lane + 4 * (j & 1));
    for (int m0 = 4 * gw; m0 < M; m0 += 4 * NGW) {
        v4u r[4][2]; float ri[4];
#pragma unroll
        for (int q = 0; q < 4; ++q) { const v4u* xr = (const v4u*)(F.XB + (size_t)(m0 + q) * D); r[q][0] = xr[F.lane]; r[q][1] = xr[64 + F.lane]; ri[q] = pg8::row_rinv(F.SS3, m0 + q); }
#pragma unroll
        for (int q = 0; q < 4; ++q) { float* orow = F.out + (size_t)(m0 + q) * D;
#pragma unroll
            for (int hh = 0; hh < 2; ++hh) { const v4u w = r[q][hh];
                const f32x4 a = (f32x4){__builtin_bit_cast(float, w.x << 16), __builtin_bit_cast(float, w.x & 0xffff0000u), __builtin_bit_cast(float, w.y << 16), __builtin_bit_cast(float, w.y & 0xffff0000u)};
                const f32x4 bq = (f32x4){__builtin_bit_cast(float, w.z << 16), __builtin_bit_cast(float, w.z & 0xffff0000u), __builtin_bit_cast(float, w.w << 16), __builtin_bit_cast(float, w.w & 0xffff0000u)};
                *(f32x4*)(orow + hh * 512 + 8 * F.lane) = a * ri[q] * g[2 * hh]; *(f32x4*)(orow + hh * 512 + 8 * F.lane + 4) = bq * ri[q] * g[2 * hh + 1]; } }
    }
}

struct Args { const float* in[18]; float* out; unsigned char* ws; int ph_lo, ph_hi; };
__global__ void __launch_bounds__(NWAVES * 64, 2) mk_fwd(Args args) {
    extern __shared__ __attribute__((aligned(16))) unsigned char lds[];
    Frame F;
    F.lds = (LAS unsigned char*)lds;
    F.tid = threadIdx.x; F.lane = F.tid & 63; F.wave = __builtin_amdgcn_readfirstlane(F.tid >> 6);
    F.G = gridDim.x; { const int bx = blockIdx.x; F.vcu = (F.G % 8 == 0) ? (bx % 8) * (F.G / 8) + bx / 8 : bx; }
    unsigned char* ws = args.ws;
    F.x = args.in[0]; F.n1 = args.in[1]; F.wg1 = args.in[2]; F.wu1 = args.in[3]; F.wd1 = args.in[4]; F.nm = args.in[5]; F.win = args.in[6]; F.qn = args.in[7]; F.kn = args.in[8];
    F.relb = args.in[9]; F.poolw = args.in[10]; F.pools = args.in[11]; F.wout = args.in[12]; F.n2 = args.in[13]; F.wg2 = args.in[14]; F.wu2 = args.in[15]; F.wd2 = args.in[16]; F.nf = args.in[17];
    F.out = args.out;
    F.SS0 = (float*)(ws + WS_SS0); F.SS1 = (float*)(ws + WS_SS1); F.SS2 = (float*)(ws + WS_SS2); F.SS3 = (float*)(ws + WS_SS3);
    F.Wgu1 = (bf16*)(ws + WS_WGU1); F.Wd1 = (bf16*)(ws + WS_WD1); F.Win = (bf16*)(ws + WS_WIN); F.Wv = (bf16*)(ws + WS_WV); F.Wout = (bf16*)(ws + WS_WOUT); F.Wgu2 = (bf16*)(ws + WS_WGU2); F.Wd2 = (bf16*)(ws + WS_WD2);
    F.XB = (bf16*)(ws + WS_XB); F.H = (bf16*)(ws + WS_H); F.QKU = (bf16*)(ws + WS_QKU); F.VT = (bf16*)(ws + WS_VT); F.CAT = (bf16*)(ws + WS_CAT);
    cg::grid_group grid = cg::this_grid();
    volatile LAS unsigned* bst = (volatile LAS unsigned*)(F.lds + LDS_BYTES - 64);
    if (F.tid < 2) bst[F.tid] = 0u;
    __syncthreads();
    XcdBarrier bar = xcd_barrier_post((unsigned*)ws, bst);
    const int lo = args.ph_lo, hi = args.ph_hi;
#define IN(k) (lo <= (k) && (k) < hi)
#define SEAM(k) do { if (IN(k) && IN((k) + 1)) { if (lo > 1000) grid.sync();   xcd_barrier(bar); } } while (0)
    const int bid = (int)blockIdx.x;

    if (IN(0)) { p0_prologue(F); SEAM(0); }
    if (IN(1)) {
        pg8::Gemm g{F.XB, F.Wgu1, M, 2 * FF, D}; pg8::StaticOrder S; S.init(M, 2 * FF, F.G, bid);
        pg8::EpiSwiGLU E{F.H, FF, F.SS0};
        pg8::gemm_phase<pg8::EpiSwiGLU, pg8::StaticOrder, true, true>(F.lds, g, S, E);
        SEAM(1);
    }
    if (IN(2)) {
        pg8::Gemm g{F.H, F.Wd1, M, D, FF}; pg8::StaticOrder S; S.init(M, D, F.G, bid);
        pg8::EpiRes<false> E{F.x, F.XB, F.SS1, 0.5f};
        pg8::gemm_phase<pg8::EpiRes<false>, pg8::StaticOrder, true, true>(F.lds, g, S, E);
        SEAM(2);
    }
    if (IN(3)) {
        { pg8::Gemm g{F.XB, F.Win, M, NPROJ, D}; pg8::StaticOrder S; S.init(M, NPROJ, F.G, bid);
          pg8::EpiProj E{F.QKU, F.SS1, F.qn, F.kn, 0.125f * LOG2E};
          pg8::gemm_phase<pg8::EpiProj, pg8::StaticOrder, true, true>(F.lds, g, S, E); }
        { pg8::Gemm g{F.Wv, F.XB, 512, M, D}; pg8::StaticOrder S; S.init(512, M, F.G, bid);
          pg8::EpiVT E{F.VT, M, F.SS1};
          pg8::gemm_phase<pg8::EpiVT, pg8::StaticOrder, true, true>(F.lds, g, S, E); }
        SEAM(3);
    }
    if (IN(4)) { pool_phase(F); attn_phase(F); SEAM(4); }
    if (IN(5)) {
        pg8::Gemm g{F.CAT, F.Wout, M, D, D}; pg8::StaticOrder S; S.init(M, D, F.G, bid);
        pg8::EpiRes<true> E{nullptr, F.XB, F.SS2, 1.0f};
        pg8::gemm_phase<pg8::EpiRes<true>, pg8::StaticOrder, true, true>(F.lds, g, S, E);
        SEAM(5);
    }
    if (IN(6)) {
        pg8::Gemm g{F.XB, F.Wgu2, M, 2 * FF, D}; pg8::StaticOrder S; S.init(M, 2 * FF, F.G, bid);
        pg8::EpiSwiGLU E{F.H, FF, F.SS2};
        pg8::gemm_phase<pg8::EpiSwiGLU, pg8::StaticOrder, true, true>(F.lds, g, S, E);
        SEAM(6);
    }
    if (IN(7)) {
        pg8::Gemm g{F.H, F.Wd2, M, D, FF}; pg8::StaticOrder S; S.init(M, D, F.G, bid);
        pg8::EpiRes<true> E{nullptr, F.XB, F.SS3, 0.5f};
        pg8::gemm_phase<pg8::EpiRes<true>, pg8::StaticOrder, true, true>(F.lds, g, S, E);
        SEAM(7);
    }
    if (IN(8)) final_norm(F);
#undef IN
#undef SEAM
}

extern "C" void kernel_launch(void* const* d_in, const int* in_sizes, int n_in, void* d_out, int out_size, void* d_ws, size_t ws_size, hipStream_t stream) {
    static int grid = 0;
    if (grid == 0) {
        if (n_in != 18 || in_sizes[0] != M * D || out_size != M * D || ws_size < WS_END) { fprintf(stderr, "kernel_launch: unexpected shapes (n_in %d, in0 %d, out %d, ws %zu); nothing launched\n", n_in, n_in > 0 ? in_sizes[0] : -1, out_size, ws_size); grid = -1; return; }
        int dev = 0, cus = 0, per_cu = 0;
        if (hipGetDevice(&dev) != hipSuccess || hipDeviceGetAttribute(&cus, hipDeviceAttributeMultiprocessorCount, dev) != hipSuccess) { grid = -1; return; }
        if (hipFuncSetAttribute((const void*)mk_fwd, hipFuncAttributeMaxDynamicSharedMemorySize, LDS_BYTES) != hipSuccess) { fprintf(stderr, "kernel_launch: hipFuncSetAttribute failed\n"); grid = -1; return; }
        if (hipOccupancyMaxActiveBlocksPerMultiprocessor(&per_cu, (const void*)mk_fwd, NWAVES * 64, LDS_BYTES) != hipSuccess || per_cu < 1) { fprintf(stderr, "kernel_launch: occupancy query says %d\n", per_cu); per_cu = 1; }
        (void)hipGetLastError();
        grid = cus * per_cu;
    }
    if (grid < 0) return;
    Args a{};
    for (int i = 0; i < 18; ++i) a.in[i] = (const float*)d_in[i];
    a.out = (float*)d_out; a.ws = (unsigned char*)d_ws;
    if (MK_N_LAUNCHES == 1) {
        if (hipMemsetAsync(d_ws, 0, 16384, stream) != hipSuccess) { fprintf(stderr, "kernel_launch: memset failed\n"); return; }
        a.ph_lo = 0; a.ph_hi = N_PHASES;
        void* kargs[] = {&a};
        const hipError_t e = hipLaunchCooperativeKernel((const void*)mk_fwd, dim3(grid), dim3(NWAVES * 64), kargs, LDS_BYTES, stream);
        if (e != hipSuccess) fprintf(stderr, "kernel_launch: cooperative launch failed: %s (grid %d)\n", hipGetErrorString(e), grid);
    } else {
        for (int p = 0; p < N_PHASES; ++p) { a.ph_lo = p; a.ph_hi = p + 1; hipLaunchKernelGGL(mk_fwd, dim3(grid), dim3(NWAVES * 64), LDS_BYTES, stream, a); }
    }
}
```

```cpp
#include <hip/hip_runtime.h>
#include <hip/hip_cooperative_groups.h>
#include <cstdio>
#include <cstdint>
#define MK_N_LAUNCHES 1
namespace pg8 {
#define PG8_LAS __attribute__((address_space(3)))
typedef unsigned short bf16_t;
typedef short bf16x8 __attribute__((ext_vector_type(8)));
typedef float f32x4 __attribute__((ext_vector_type(4)));
typedef unsigned u32x4 __attribute__((ext_vector_type(4)));
constexpr int BM = 256, BK = 64, HALF = 128, HTB = HALF * BK * 2  , STAGE_BYTES = 8 * HTB, NXCD = 8, WGM = 8;

__host__ __device__ __forceinline__ int lds_byte(int r, int c) { const int st = (r >> 4) * 2 + (c >> 5), rr = r & 15, cc = c & 31, ob = rr * 64 + cc * 2; return st * 1024 + (ob ^ (((ob >> 9) & 1) << 5)); }
__host__ __device__ __forceinline__ void stage_rc(int b, int& R, int& C) { const int st = b / 1024, sb = b % 1024, swz = sb ^ (((sb >> 9) & 1) << 5); R = (st >> 1) * 16 + swz / 64; C = (st & 1) * 32 + (swz % 64) / 2; }
__host__ __device__ __forceinline__ int perm32(int rho) { const int n = rho >> 4, i = rho & 15; return 8 * (i >> 2) + 4 * n + (i & 3); }

struct Unit { int pm, pn; };
struct Gemm { const bf16_t* A; const bf16_t* Bt; int M, N, K; };

struct StaticOrder {
    int nM, nN, nwg, G, c;
    __host__ __device__ void init(int M, int N, int G_, int c_) { nM = M / BM; nN = N / BM; nwg = nM * nN; G = G_; c = c_; }
    __host__ __device__ bool next(int i, Unit& u) const {
        const long L = (long)i * G + c; if (L >= nwg) return false;
        int wgid = (int)L; { const int q = nwg / NXCD, r = nwg % NXCD, xcd = wgid % NXCD, off = wgid / NXCD; wgid = (xcd < r ? xcd * (q + 1) : r * (q + 1) + (xcd - r) * q) + off; }
        const int nig = WGM * nN, gid = wgid / nig, fm = gid * WGM, gsz = (nM - fm) < WGM ? (nM - fm) : WGM;
        u.pm = fm + ((wgid % nig) % gsz); u.pn = (wgid % nig) / gsz; return true;
    }
    __device__ __forceinline__ void a_ready(const Unit&) const {}
    __device__ __forceinline__ void done(const Unit&) const {}
};

__device__ __forceinline__ unsigned cvt_pk_bf16(float lo, float hi) { unsigned r; asm volatile("v_cvt_pk_bf16_f32 %0, %1, %2" : "=v"(r) : "v"(lo), "v"(hi)); return r; }
typedef float f32x2 __attribute__((ext_vector_type(2)));
__device__ __forceinline__ float row_rinv(const float* ss, int row) {
    const f32x4* p = (const f32x4*)(ss + (size_t)row * 16);
    const f32x4 a = p[0], b = p[1], c = p[2], d = p[3];
    const float s = (((a[0] + a[1]) + (a[2] + a[3])) + ((b[0] + b[1]) + (b[2] + b[3]))) + (((c[0] + c[1]) + (c[2] + c[3])) + ((d[0] + d[1]) + (d[2] + d[3])));
    return __builtin_amdgcn_rsqf(s * (1.0f / 1024.0f) + 1e-6f);
}
__device__ __forceinline__ float silu_f(float x) { return x * __builtin_amdgcn_rcpf(1.0f + __builtin_amdgcn_exp2f(-1.4426950408889634f * x)); }

struct EpiSwiGLU {
    static constexpr bool PERM = true, AFTER_DRAIN = false;
    bf16_t* O; int ldc; const float* ss;
    __device__ __forceinline__ void operator()(const f32x4 (&acc)[2][2][4][2], const Unit& u, int wr, int wc, int fr, int fq) const {
        const int row0 = u.pm * BM + wr * 64 + fr, col0 = u.pn * 128 + wc * 32 + 8 * fq;
#pragma unroll
        for (int ai = 0; ai < 2; ++ai)
#pragma unroll
            for (int m = 0; m < 4; ++m) { const int row = row0 + ai * HALF + m * 16; const float ri = row_rinv(ss, row);
                const f32x4 g0 = acc[ai][0][m][0] * ri, g1 = acc[ai][0][m][1] * ri, u0 = acc[ai][1][m][0] * ri, u1 = acc[ai][1][m][1] * ri;
                float h[8];
#pragma unroll
                for (int j = 0; j < 4; ++j) { h[j] = silu_f(g0[j]) * u0[j]; h[4 + j] = silu_f(g1[j]) * u1[j]; }
                u32x4 w; w.x = cvt_pk_bf16(h[0], h[1]); w.y = cvt_pk_bf16(h[2], h[3]); w.z = cvt_pk_bf16(h[4], h[5]); w.w = cvt_pk_bf16(h[6], h[7]);
                *(u32x4*)(O + (size_t)row * ldc + col0) = w; }
    }
};

template <bool BASE_BF16> struct EpiRes {
    static constexpr bool PERM = true, AFTER_DRAIN = false;
    const float* base; bf16_t* xb; float* ss_out; float alpha;
    __device__ __forceinline__ void operator()(const f32x4 (&acc)[2][2][4][2], const Unit& u, int wr, int wc, int fr, int fq) const {
        const int row0 = u.pm * BM + wr * 64 + fr, col0 = u.pn * BM + wc * 32 + 8 * fq;
#pragma unroll
        for (int ai = 0; ai < 2; ++ai)
#pragma unroll
            for (int m = 0; m < 4; ++m) { const int row = row0 + ai * HALF + m * 16; float sq = 0.f;
#pragma unroll
                for (int bj = 0; bj < 2; ++bj) { const size_t off = (size_t)row * 1024 + col0 + bj * HALF;
                    f32x4 b0, b1;
                    if (BASE_BF16) { const u32x4 r = *(const u32x4*)(xb + off);
                        b0 = (f32x4){__builtin_bit_cast(float, r.x << 16), __builtin_bit_cast(float, r.x & 0xffff0000u), __builtin_bit_cast(float, r.y << 16), __builtin_bit_cast(float, r.y & 0xffff0000u)};
                        b1 = (f32x4){__builtin_bit_cast(float, r.z << 16), __builtin_bit_cast(float, r.z & 0xffff0000u), __builtin_bit_cast(float, r.w << 16), __builtin_bit_cast(float, r.w & 0xffff0000u)}; }
                    else { b0 = *(const f32x4*)(base + off); b1 = *(const f32x4*)(base + off + 4); }
                    const f32x4 v0 = b0 + acc[ai][bj][m][0] * alpha, v1 = b1 + acc[ai][bj][m][1] * alpha;
                    u32x4 w; w.x = cvt_pk_bf16(v0[0], v0[1]); w.y = cvt_pk_bf16(v0[2], v0[3]); w.z = cvt_pk_bf16(v1[0], v1[1]); w.w = cvt_pk_bf16(v1[2], v1[3]); *(u32x4*)(xb + off) = w;
                    sq += ((v0[0] * v0[0] + v0[1] * v0[1]) + (v0[2] * v0[2] + v0[3] * v0[3])) + ((v1[0] * v1[0] + v1[1] * v1[1]) + (v1[2] * v1[2] + v1[3] * v1[3])); }
                sq += __shfl_xor(sq, 16); sq += __shfl_xor(sq, 32);
                if (fq == 0) ss_out[(size_t)row * 16 + u.pn * 4 + wc] = sq; }
    }
};

struct EpiProj {
    static constexpr bool PERM = true, AFTER_DRAIN = false;
    bf16_t* O; const float* ss; const float* qg; const float* kg; float qscale;
    __device__ __forceinline__ void operator()(const f32x4 (&acc)[2][2][4][2], const Unit& u, int wr, int wc, int fr, int fq) const {
        const int row0 = u.pm * BM + wr * 64 + fr, col0 = u.pn * BM + wc * 64 + 8 * fq;
        const int kind = u.pn >> 1;
        float gn[2][8];
#pragma unroll
        for (int bj = 0; bj < 2; ++bj)
#pragma unroll
            for (int e = 0; e < 8; ++e) gn[bj][e] = 1.f;
        if (kind < 2) { const float* gp = kind == 0 ? qg : kg; const float sc = kind == 0 ? qscale : 1.f;
#pragma unroll
            for (int bj = 0; bj < 2; ++bj)
#pragma unroll
                for (int e = 0; e < 8; ++e) gn[bj][e] = gp[32 * bj + 8 * fq + e] * sc; }
#pragma unroll
        for (int ai = 0; ai < 2; ++ai)
#pragma unroll
            for (int m = 0; m < 4; ++m) { const int row = row0 + ai * HALF + m * 16; const float ri = row_rinv(ss, row);
                f32x4 v[2][2]; float sq = 0.f;
#pragma unroll
                for (int bj = 0; bj < 2; ++bj)
#pragma unroll
                    for (int n = 0; n < 2; ++n) { v[bj][n] = acc[ai][bj][m][n] * ri; const f32x4 t = v[bj][n]; sq += (t[0] * t[0] + t[1] * t[1]) + (t[2] * t[2] + t[3] * t[3]); }
                float hr = 1.f;
                if (kind < 2) { sq += __shfl_xor(sq, 16); sq += __shfl_xor(sq, 32); hr = __builtin_amdgcn_rsqf(sq * (1.0f / 64.0f) + 1e-6f); }
#pragma unroll
                for (int bj = 0; bj < 2; ++bj) { const f32x4 a = v[bj][0], b = v[bj][1]; u32x4 w;
                    w.x = cvt_pk_bf16(a[0] * hr * gn[bj][0], a[1] * hr * gn[bj][1]); w.y = cvt_pk_bf16(a[2] * hr * gn[bj][2], a[3] * hr * gn[bj][3]);
                    w.z = cvt_pk_bf16(b[0] * hr * gn[bj][4], b[1] * hr * gn[bj][5]); w.w = cvt_pk_bf16(b[2] * hr * gn[bj][6], b[3] * hr * gn[bj][7]);
                    *(u32x4*)(O + (size_t)row * 1536 + col0 + bj * 32) = w; } }
    }
};

struct EpiVT {
    static constexpr bool PERM = true, AFTER_DRAIN = false;
    bf16_t* O; int ldc; const float* ss;
    __device__ __forceinline__ void operator()(const f32x4 (&acc)[2][2][4][2], const Unit& u, int wr, int wc, int fr, int fq) const {
        const int row0 = u.pm * BM + wr * 64 + fr, col0 = u.pn * BM + wc * 32 + 8 * fq;
        float ri[2][8];
#pragma unroll
        for (int bj = 0; bj < 2; ++bj)
#pragma unroll
            for (int e = 0; e < 8; ++e) ri[bj][e] = row_rinv(ss, col0 + bj * HALF + e);
#pragma unroll
        for (int ai = 0; ai < 2; ++ai)
#pragma unroll
            for (int m = 0; m < 4; ++m) { const int row = row0 + ai * HALF + m * 16;
#pragma unroll
                for (int bj = 0; bj < 2; ++bj) { const f32x4 a = acc[ai][bj][m][0], b = acc[ai][bj][m][1]; u32x4 w;
                    w.x = cvt_pk_bf16(a[0] * ri[bj][0], a[1] * ri[bj][1]); w.y = cvt_pk_bf16(a[2] * ri[bj][2], a[3] * ri[bj][3]);
                    w.z = cvt_pk_bf16(b[0] * ri[bj][4], b[1] * ri[bj][5]); w.w = cvt_pk_bf16(b[2] * ri[bj][6], b[3] * ri[bj][7]);
                    *(u32x4*)(O + (size_t)row * ldc + col0 + bj * HALF) = w; } }
    }
};

template <class Epi, class Sched, bool ALIGN_EPI = false, bool SP2 = false>
__device__ __forceinline__ void gemm_phase(PG8_LAS unsigned char* lds, const Gemm g, const Sched& S, const Epi& E) {
    const int tid = threadIdx.x, wid = __builtin_amdgcn_readfirstlane(tid >> 6), lane = tid & 63, wr = wid >> 2, wc = wid & 3, fr = lane & 15, fq = lane >> 4;
    const int K = g.K, nt = K / BK;
    unsigned voffA[2], voffB[2];
#pragma unroll
    for (int i = 0; i < 2; ++i) { int R, C; stage_rc(tid * 16 + i * 8192, R, C); const int Rb = Epi::PERM ? ((R & ~31) + perm32(R & 31)) : R;
        voffA[i] = (unsigned)(R * K + C) * 2u; voffB[i] = (unsigned)(Rb * K + C) * 2u; }
    const size_t kstep = (size_t)(BK * 2);
    const size_t hstep = (size_t)HALF * K * 2;
    const size_t tstep = 2 * hstep;
    const unsigned ldsw = (unsigned)wid * 1024u;
    const int aoff = lds_byte(wr * 64 + fr, fq * 8), boff = lds_byte(wc * 32 + fr, fq * 8);
#define PG8_SA(b, h) (((b) * 2 + (h)) * HTB)
#define PG8_SB(b, h) ((4 + (b) * 2 + (h)) * HTB)
#define PG8_STAGE(bufoff, gbase, voff) do { _Pragma("unroll") for (int _i = 0; _i < 2; ++_i) \
        __builtin_amdgcn_global_load_lds((const unsigned*)((const char*)(gbase) + (voff)[_i]), (PG8_LAS unsigned*)(lds + (bufoff) + ldsw + _i * 8192), 16, 0, 0); } while (0)
#define PG8_LDA(dst, b, h) do { _Pragma("unroll") for (int m = 0; m < 4; ++m) _Pragma("unroll") for (int k = 0; k < 2; ++k) dst[m][k] = *(const PG8_LAS bf16x8*)(lds + PG8_SA(b, h) + aoff + m * 2048 + k * 1024); } while (0)
#define PG8_LDB(dst, b, h) do { _Pragma("unroll") for (int n = 0; n < 2; ++n) _Pragma("unroll") for (int k = 0; k < 2; ++k) dst[n][k] = *(const PG8_LAS bf16x8*)(lds + PG8_SB(b, h) + boff + n * 2048 + k * 1024); } while (0)
#define PG8_MMA(ai, bj, At, Bt) do { __builtin_amdgcn_s_setprio(1); _Pragma("unroll") for (int m = 0; m < 4; ++m) _Pragma("unroll") for (int n = 0; n < 2; ++n) _Pragma("unroll") for (int k = 0; k < 2; ++k) \
        acc[ai][bj][m][n] = __builtin_amdgcn_mfma_f32_16x16x32_bf16(Bt[n][k], At[m][k], acc[ai][bj][m][n], 0, 0, 0); __builtin_amdgcn_s_setprio(0); } while (0)
#define PG8_WAIT_V(n) asm volatile("s_waitcnt vmcnt(" #n ")" ::: "memory")
#define PG8_WAIT_L(n) asm volatile("s_waitcnt lgkmcnt(" #n ")" ::: "memory")
#define PG8_BAR __builtin_amdgcn_s_barrier()
#define PG8_SCHED __builtin_amdgcn_sched_barrier(0)
    Unit cur, nxt; int ui = 0;
    if (!S.next(0, cur)) return;
    f32x4 acc[2][2][4][2];
#pragma unroll
    for (int a = 0; a < 2; ++a)
#pragma unroll
        for (int b = 0; b < 2; ++b)
#pragma unroll
            for (int m = 0; m < 4; ++m)
#pragma unroll
                for (int n = 0; n < 2; ++n) acc[a][b][m][n] = (f32x4){0.f, 0.f, 0.f, 0.f};
    bf16x8 At[4][2], B0[2][2], B1[2][2];
    const char* cA = (const char*)g.A + (size_t)cur.pm * tstep; const char* cB = (const char*)g.Bt + (size_t)cur.pn * tstep;
    S.a_ready(cur);
    if constexpr (SP2) {
        PG8_STAGE(PG8_SB(0, 0), cB, voffB); PG8_STAGE(PG8_SB(0, 1), cB + hstep, voffB); PG8_STAGE(PG8_SA(0, 0), cA, voffA); PG8_STAGE(PG8_SA(0, 1), cA + hstep, voffA);
        if (wr == 1) PG8_BAR;
        PG8_WAIT_V(2); PG8_BAR;
        PG8_STAGE(PG8_SB(1, 0), cB + kstep, voffB); PG8_STAGE(PG8_SA(1, 0), cA + kstep, voffA); PG8_STAGE(PG8_SB(1, 1), cB + hstep + kstep, voffB);
        PG8_WAIT_V(6); PG8_BAR;
    } else {
        PG8_STAGE(PG8_SB(0, 0), cB, voffB); PG8_STAGE(PG8_SA(0, 0), cA, voffA); PG8_STAGE(PG8_SB(0, 1), cB + hstep, voffB); PG8_STAGE(PG8_SA(0, 1), cA + hstep, voffA);
        if (wr == 1) PG8_BAR;
        PG8_WAIT_V(4); PG8_BAR;
        PG8_STAGE(PG8_SB(1, 0), cB + kstep, voffB); PG8_STAGE(PG8_SA(1, 0), cA + kstep, voffA); PG8_STAGE(PG8_SB(1, 1), cB + hstep + kstep, voffB);
        PG8_WAIT_V(6); PG8_BAR;
    }
    for (;;) {
        const bool has_next = S.next(ui + 1, nxt);
        const char* nA = has_next ? (const char*)g.A + (size_t)nxt.pm * tstep : cA; const char* nB = has_next ? (const char*)g.Bt + (size_t)nxt.pn * tstep : cB;
        for (int t = 0; t < nt; t += 2) {
            const bool last = (t == nt - 2);
            const char* a1 = cA + (size_t)(t + 1) * kstep;
            const char* a2 = last ? nA : cA + (size_t)(t + 2) * kstep; const char* b2 = last ? nB : cB + (size_t)(t + 2) * kstep;
            const char* a3 = a2 + kstep; const char* b3 = b2 + kstep;
            if (last && has_next) S.a_ready(nxt);
            if constexpr (SP2) {
            PG8_LDB(B0, 0, 0); PG8_LDB(B1, 0, 1); PG8_SCHED; PG8_LDA(At, 0, 0); PG8_STAGE(PG8_SA(1, 1), a1 + hstep, voffA);
            PG8_WAIT_V(8); PG8_WAIT_L(0); PG8_BAR; PG8_MMA(0, 0, At, B0); PG8_MMA(0, 1, At, B1); PG8_BAR; PG8_SCHED;
            PG8_LDA(At, 0, 1); PG8_STAGE(PG8_SB(0, 0), b2, voffB); PG8_STAGE(PG8_SB(0, 1), b2 + hstep, voffB); PG8_STAGE(PG8_SA(0, 0), a2, voffA);
            PG8_WAIT_V(8); PG8_WAIT_L(0); PG8_BAR; PG8_MMA(1, 0, At, B0); PG8_MMA(1, 1, At, B1); PG8_BAR; PG8_SCHED;
            PG8_LDB(B0, 1, 0); PG8_LDB(B1, 1, 1); PG8_SCHED; PG8_LDA(At, 1, 0); PG8_STAGE(PG8_SA(0, 1), a2 + hstep, voffA);
            PG8_WAIT_V(8); PG8_WAIT_L(0); PG8_BAR; PG8_MMA(0, 0, At, B0); PG8_MMA(0, 1, At, B1); PG8_BAR; PG8_SCHED;
            PG8_LDA(At, 1, 1); PG8_STAGE(PG8_SB(1, 0), b3, voffB); PG8_STAGE(PG8_SB(1, 1), b3 + hstep, voffB); PG8_STAGE(PG8_SA(1, 0), a3, voffA);
            PG8_WAIT_V(8); PG8_WAIT_L(0); PG8_BAR; PG8_MMA(1, 0, At, B0); PG8_MMA(1, 1, At, B1); PG8_BAR; PG8_SCHED;
            } else {
            PG8_LDB(B0, 0, 0); PG8_SCHED; PG8_LDA(At, 0, 0); PG8_STAGE(PG8_SA(1, 1), a1 + hstep, voffA);
            PG8_WAIT_L(8); PG8_BAR; PG8_WAIT_L(0); PG8_MMA(0, 0, At, B0); PG8_BAR; PG8_SCHED;
            PG8_LDB(B1, 0, 1); PG8_STAGE(PG8_SB(0, 0), b2, voffB);
            PG8_BAR; PG8_WAIT_L(0); PG8_MMA(0, 1, At, B1); PG8_BAR;
            PG8_LDA(At, 0, 1); PG8_STAGE(PG8_SA(0, 0), a2, voffA);
            PG8_BAR; PG8_WAIT_L(0); PG8_MMA(1, 0, At, B0); PG8_BAR; PG8_SCHED;
            PG8_STAGE(PG8_SB(0, 1), b2 + hstep, voffB);
            PG8_WAIT_V(6); PG8_BAR; PG8_MMA(1, 1, At, B1); PG8_BAR;
            PG8_LDB(B0, 1, 0); PG8_SCHED; PG8_LDA(At, 1, 0); PG8_STAGE(PG8_SA(0, 1), a2 + hstep, voffA);
            PG8_WAIT_L(8); PG8_BAR; PG8_WAIT_L(0); PG8_MMA(0, 0, At, B0); PG8_BAR; PG8_SCHED;
            PG8_LDB(B1, 1, 1); PG8_STAGE(PG8_SB(1, 0), b3, voffB);
            PG8_BAR; PG8_WAIT_L(0); PG8_MMA(0, 1, At, B1); PG8_BAR;
            PG8_LDA(At, 1, 1); PG8_STAGE(PG8_SA(1, 0), a3, voffA);
            PG8_BAR; PG8_WAIT_L(0); PG8_MMA(1, 0, At, B0); PG8_BAR; PG8_SCHED;
            PG8_STAGE(PG8_SB(1, 1), b3 + hstep, voffB);
            PG8_WAIT_V(6); PG8_BAR; PG8_MMA(1, 1, At, B1); PG8_BAR;
            }
        }
        if constexpr (ALIGN_EPI) { if (wr == 0) PG8_BAR; }
        if constexpr (!Epi::AFTER_DRAIN) { E(acc, cur, wr, wc, fr, fq); S.done(cur); }
        if (!has_next) break;
#pragma unroll
        for (int a = 0; a < 2; ++a)
#pragma unroll
            for (int b = 0; b < 2; ++b)
#pragma unroll
                for (int m = 0; m < 4; ++m)
#pragma unroll
                    for (int n = 0; n < 2; ++n) acc[a][b][m][n] = (f32x4){0.f, 0.f, 0.f, 0.f};
        cur = nxt; cA = nA; cB = nB; ++ui;
        if constexpr (ALIGN_EPI) { if (wr == 1) PG8_BAR; }
    }
    PG8_WAIT_V(0);
    if constexpr (!ALIGN_EPI) { if (wr == 0) PG8_BAR; }
    PG8_BAR;
    if constexpr (Epi::AFTER_DRAIN) { E.fused(acc, cur, wr, wc, fr, fq, lds, wid, lane); S.done(cur); }
#undef PG8_SA
#undef PG8_SB
#undef PG8_STAGE
#undef PG8_LDA
#undef PG8_LDB
#undef PG8_MMA
#undef PG8_WAIT_V
#undef PG8_WAIT_L
#undef PG8_BAR
#undef PG8_SCHED
}
}

namespace cg = cooperative_groups;
#define GAS __attribute__((address_space(1)))
#define LAS __attribute__((address_space(3)))
typedef unsigned short bf16;
typedef unsigned v4u __attribute__((ext_vector_type(4)));
typedef unsigned v2u __attribute__((ext_vector_type(2)));
typedef float f32x4 __attribute__((ext_vector_type(4)));
typedef short bf16x8 __attribute__((ext_vector_type(8)));
typedef float f32x16 __attribute__((ext_vector_type(16)));

constexpr int NWAVES = 8;
constexpr int BATCH = 8, SEQ = 4096, D = 1024, FF = 2816, DA = 512, HD = 64, NH = 8, DP = 512, NREL = 257;
constexpr int M = BATCH * SEQ;
constexpr int NPROJ = 1536;
constexpr float LOG2E = 1.4426950408889634f;
#ifndef MK_N_LAUNCHES
#define MK_N_LAUNCHES 1
#endif
constexpr int N_PHASES = 9;

constexpr size_t MiB = 1u << 20;
constexpr size_t WS_SS0 = 2 * MiB, WS_SS1 = 4 * MiB, WS_SS2 = 6 * MiB, WS_SS3 = 8 * MiB;
constexpr size_t WS_WGU1 = 10 * MiB, WS_WD1 = 21 * MiB, WS_WIN = 27 * MiB, WS_WV = 30 * MiB, WS_WOUT = 31 * MiB, WS_WGU2 = 33 * MiB, WS_WD2 = 44 * MiB;
constexpr size_t WS_XB = 50 * MiB;
constexpr size_t WS_H = 114 * MiB;
constexpr size_t WS_QKU = 114 * MiB, WS_VT = 210 * MiB, WS_CAT = 242 * MiB, WS_END = 306 * MiB;
static_assert(WS_H + (size_t)M * FF * 2 <= WS_END && WS_QKU + (size_t)M * NPROJ * 2 <= WS_VT && WS_VT + (size_t)512 * M * 2 <= WS_CAT && WS_CAT + (size_t)M * 1024 * 2 <= WS_END, "ws map");

constexpr int STAGE_LDS = 131072, LDS_BYTES = 143360;

#define LDS_WAIT() asm volatile("s_waitcnt lgkmcnt(0)" ::: "memory")
__device__ __forceinline__ unsigned f2bf(float f) { unsigned u = __builtin_bit_cast(unsigned, f); return (u + 0x7fffu + ((u >> 16) & 1u)) >> 16; }
__device__ __forceinline__ unsigned pk2(float lo, float hi) { return f2bf(lo) | (f2bf(hi) << 16); }
__device__ __forceinline__ float bf2f(unsigned short b) { return __builtin_bit_cast(float, (unsigned)b << 16); }
__device__ __forceinline__ float wave_sum(float v) {
#pragma unroll
    for (int o = 1; o < 64; o <<= 1) v += __shfl_xor(v, o);
    return v;
}

#define XB_TMO      128
#define XB_XCNT(j)  (256  + 64 * (j))
#define XB_XSUB(j)  (1280 + 64 * (j))
#define XB_XGEN(j)  (2304 + 64 * (j))
#define XB_TOP      3328
#define XB_TOPGEN   3392
#define XCD_BAR_WORDS 3456
#define XB_SPIN_CAP (1u << 18)

__device__ __forceinline__ unsigned xb_ld(unsigned* p)              { return __hip_atomic_load(p, __ATOMIC_RELAXED, __HIP_MEMORY_SCOPE_AGENT); }
__device__ __forceinline__ unsigned xb_add(unsigned* p, unsigned v) { return __hip_atomic_fetch_add(p, v, __ATOMIC_RELAXED, __HIP_MEMORY_SCOPE_AGENT); }
__device__ __forceinline__ unsigned xb_xcc_id() { return (unsigned)__builtin_amdgcn_s_getreg((3 << 11) | 20) & 0xFu; }
#define XB_SPIN(cond, bar) do { unsigned _sp = 0; while (cond) { __builtin_amdgcn_s_sleep(1); \
    if ((++_sp & 255u) == 0u) { if (xb_ld(&(bar)[XB_TMO])) break; if (_sp > XB_SPIN_CAP) { atomicAdd(&(bar)[XB_TMO], 1u); break; } } } } while (0)

struct XcdBarrier {
    unsigned* bar; unsigned x;
    volatile LAS unsigned* st;
};

__device__ __forceinline__ XcdBarrier xcd_barrier_post(unsigned* bar, volatile LAS unsigned* st) {
    XcdBarrier b; b.bar = bar; b.x = xb_xcc_id(); b.st = st;
    if (threadIdx.x == 0) (void)xb_add(&bar[XB_XCNT(b.x)], 1u);
    return b;
}
__device__ __forceinline__ void xcd_barrier_complete(unsigned* bar, unsigned x, unsigned& nloc, unsigned& nx) {
    const unsigned G = gridDim.x * gridDim.y * gridDim.z;
    unsigned sum, cnt, mine, sp = 0u;
    for (;;) {
        sum = 0u; cnt = 0u; mine = 0u;
#pragma unroll
        for (unsigned j = 0; j < 16; ++j) { const unsigned c = xb_ld(&bar[XB_XCNT(j)]); sum += c; cnt += (c > 0u) ? 1u : 0u; mine = (j == x) ? c : mine; }
        if (sum == G) break;
        __builtin_amdgcn_s_sleep(1);
        if ((++sp & 255u) == 0u) { if (xb_ld(&bar[XB_TMO])) break; if (sp > XB_SPIN_CAP) { atomicAdd(&bar[XB_TMO], 1u); break; } }
    }
    nloc = mine > 0u ? mine : 1u; nx = cnt > 0u ? cnt : 1u;
}

__device__ __forceinline__ void xcd_barrier(const XcdBarrier& b) {
    asm volatile("s_waitcnt vmcnt(0)" ::: "memory");
    __syncthreads();
    if (threadIdx.x == 0) {
        unsigned* bar = b.bar;
        __builtin_amdgcn_s_waitcnt(0);
        unsigned nloc = b.st[0], nx = b.st[1];
        if (nloc == 0u) { xcd_barrier_complete(bar, b.x, nloc, nx); b.st[0] = nloc; b.st[1] = nx; }
        const unsigned old = xb_add(&bar[XB_XSUB(b.x)], 1u);
        const unsigned gen = old / nloc;
        if (old + 1u == (gen + 1u) * nloc) {
            __builtin_amdgcn_fence(__ATOMIC_RELEASE, "agent");
            asm volatile("s_waitcnt vmcnt(0)" ::: "memory");
            const unsigned og = xb_add(&bar[XB_TOP], 1u);
            const unsigned tg = og / nx;
            if (og + 1u == (tg + 1u) * nx) xb_add(&bar[XB_TOPGEN], 1u);
            else XB_SPIN(xb_ld(&bar[XB_TOPGEN]) == tg, bar);
            __builtin_amdgcn_fence(__ATOMIC_ACQUIRE, "agent");
            xb_add(&bar[XB_XGEN(b.x)], 1u);
            asm volatile("s_waitcnt vmcnt(0)" ::: "memory");
        } else {
            XB_SPIN(xb_ld(&bar[XB_XGEN(b.x)]) == gen, bar);
            __builtin_amdgcn_fence(__ATOMIC_ACQUIRE, "agent");
            asm volatile("s_waitcnt vmcnt(0)" ::: "memory");
        }
    }
    __syncthreads();
}

struct Frame {
    LAS unsigned char* lds;
    int tid, lane, wave, vcu, G;
    const float *x, *n1, *wg1, *wu1, *wd1, *nm, *win, *qn, *kn, *relb, *poolw, *pools, *wout, *n2, *wg2, *wu2, *wd2, *nf;
    float* out;
    float *SS0, *SS1, *SS2, *SS3;
    bf16 *Wgu1, *Wd1, *Win, *Wv, *Wout, *Wgu2, *Wd2, *XB, *H, *QKU, *VT, *CAT;
};

__device__ __forceinline__ void transpose_item(const float* W, int Nsrc, int k0, int srccol0, const float* gain, bf16* WT, int Kdst, int dstrow0, LAS float* scr, int lane) {
#pragma unroll
    for (int i = 0; i < 32; ++i) { const int kk = 2 * i + (lane >> 5); const float g = gain ? gain[k0 + kk] : 1.f; scr[kk * 33 + (lane & 31)] = W[(size_t)(k0 + kk) * Nsrc + srccol0 + (lane & 31)] * g; }
    LDS_WAIT(); asm volatile("" ::: "memory");
    const int c = lane & 7;
#pragma unroll
    for (int j = 0; j < 4; ++j) { const int n = (lane >> 3) + 8 * j; const LAS float* s = scr + (8 * c) * 33 + n;
        v4u o; o.x = pk2(s[0 * 33], s[1 * 33]); o.y = pk2(s[2 * 33], s[3 * 33]); o.z = pk2(s[4 * 33], s[5 * 33]); o.w = pk2(s[6 * 33], s[7 * 33]);
        *(v4u*)(WT + (size_t)(dstrow0 + n) * Kdst + k0 + 8 * c) = o; }
    LDS_WAIT(); asm volatile("" ::: "memory");
}
__device__ __forceinline__ void gu_item(const float* wg, const float* wu, const float* gain, bf16* WT, int item, LAS float* scr, int lane) {
    const int nblk = (2 * FF) / 32, kb = item / nblk, nb = item % nblk, n0 = 32 * nb;
    const int pn = n0 >> 8, bj = (n0 >> 7) & 1, i0 = n0 & 127;
    transpose_item(bj ? wu : wg, FF, 64 * kb, 128 * pn + i0, gain, WT, D, n0, scr, lane);
}
__device__ __forceinline__ void plain_item(const float* W, int K, int N, int srccol_off, int Nsrc, const float* gain, bf16* WT, int item, LAS float* scr, int lane) {
    const int nblk = N / 32, kb = item / nblk, nb = item % nblk;
    transpose_item(W, Nsrc, 64 * kb, srccol_off + 32 * nb, gain, WT, K, 32 * nb, scr, lane);
}
__device__ __forceinline__ void qk_item(const float* win, const float* gain, bf16* WT, int item, LAS float* scr, int lane) {
    const int nblk = 1024 / 32, kb = item / nblk, nb = item % nblk, n0 = 32 * nb;
    const int pn = n0 >> 8, bj = (n0 >> 7) & 1, wc = (n0 >> 5) & 3;
    transpose_item(win, 2048, 64 * kb, 256 * pn + 64 * wc + 32 * bj, gain, WT, D, n0, scr, lane);
}

__device__ __forceinline__ void p0_prologue(Frame& F) {
    {
        const int xw = F.vcu * NWAVES + F.wave, NXW = F.G * NWAVES;
        for (int m = 4 * xw; m < M; m += 4 * NXW) {
            const f32x4* xr = (const f32x4*)(F.x + (size_t)m * D) + F.lane; f32x4 v[16]; float s[4] = {0.f, 0.f, 0.f, 0.f};
#pragma unroll
            for (int j = 0; j < 16; ++j) v[j] = xr[64 * j];
#pragma unroll
            for (int j = 0; j < 16; ++j) s[j >> 2] += (v[j][0] * v[j][0] + v[j][1] * v[j][1]) + (v[j][2] * v[j][2] + v[j][3] * v[j][3]);
#pragma unroll
            for (int r = 0; r < 4; ++r) s[r] = wave_sum(s[r]);
            v2u* o8 = (v2u*)(F.XB + (size_t)m * D) + F.lane;
#pragma unroll
            for (int j = 0; j < 16; ++j) { v2u w; w.x = pk2(v[j][0], v[j][1]); w.y = pk2(v[j][2], v[j][3]); o8[64 * j] = w; }
            const int r = F.lane >> 4; const float sv = r == 0 ? s[0] : (r == 1 ? s[1] : (r == 2 ? s[2] : s[3]));
            F.SS0[(size_t)m * 16 + F.lane] = (F.lane & 15) == 0 ? sv : 0.f;
        }
    }
    LAS float* scr = (LAS float*)(F.lds + F.wave * 16384);
    const int gw = F.vcu * NWAVES + F.wave, NGW = F.G * NWAVES;
    constexpr int I_GU = (D / 64) * (2 * FF / 32), I_D = (FF / 64) * (D / 32), I_QK = (D / 64) * (1024 / 32), I_V = (D / 64) * (512 / 32), I_O = (D / 64) * (D / 32);
    constexpr int NITEMS = 2 * I_GU + 2 * I_D + I_QK + I_V + I_O;
    for (int it = gw; it < (D / 4) * 8; it += NGW) {
        const int k0 = (it >> 3) * 4, cb = it & 7, ucol = cb * 64 + F.lane, g = cb >> 1, d = ucol & 127;
        const float* wrow = F.win + (size_t)k0 * 2048 + 1536 + g * 128; const float* pw = F.poolw + (size_t)g * 128 * 128 + d;
        float a0 = 0.f, a1 = 0.f, a2 = 0.f, a3 = 0.f;
#pragma unroll 16
        for (int c = 0; c < 128; ++c) { const float p = pw[(size_t)c * 128]; a0 += wrow[c] * p; a1 += wrow[2048 + c] * p; a2 += wrow[4096 + c] * p; a3 += wrow[6144 + c] * p; }
        const float ps = F.pools[ucol];
        const int t = ucol >> 8, wc = (ucol >> 6) & 3, bj = (ucol >> 5) & 1, i = ucol & 31;
        v2u w; w.x = pk2(a0 * ps * F.nm[k0], a1 * ps * F.nm[k0 + 1]); w.y = pk2(a2 * ps * F.nm[k0 + 2], a3 * ps * F.nm[k0 + 3]);
        *(v2u*)(F.Win + (size_t)(1024 + 256 * t + 128 * bj + 32 * wc + i) * D + k0) = w;
    }
    for (int it = gw; it < NITEMS; it += NGW) {
        int r = it;
        if (r < I_GU) { gu_item(F.wg1, F.wu1, F.n1, F.Wgu1, r, scr, F.lane); continue; } r -= I_GU;
        if (r < I_GU) { gu_item(F.wg2, F.wu2, F.n2, F.Wgu2, r, scr, F.lane); continue; } r -= I_GU;
        if (r < I_D) { plain_item(F.wd1, FF, D, 0, D, nullptr, F.Wd1, r, scr, F.lane); continue; } r -= I_D;
        if (r < I_D) { plain_item(F.wd2, FF, D, 0, D, nullptr, F.Wd2, r, scr, F.lane); continue; } r -= I_D;
        if (r < I_QK) { qk_item(F.win, F.nm, F.Win, r, scr, F.lane); continue; } r -= I_QK;
        if (r < I_V) { plain_item(F.win, D, 512, 1024, 2048, F.nm, F.Wv, r, scr, F.lane); continue; } r -= I_V;
        plain_item(F.wout, D, D, 0, D, nullptr, F.Wout, r, scr, F.lane);
    }
}

__device__ __forceinline__ void pool_phase(Frame& F) {
    const int gt = F.vcu * (NWAVES * 64) + F.tid, NT = F.G * NWAVES * 64;
    for (int it = gt; it < M * 64; it += NT) {
        const int tok = it >> 6, cgp = it & 63, s = tok & (SEQ - 1), g = cgp >> 4, w = 2 << g;
        const int n = (s + 1 < w) ? s + 1 : w;
        const bf16* up = F.QKU + (size_t)tok * NPROJ + 1024 + cgp * 8;
        float acc[8], cur[8];
        { const bf16x8 v = *(const bf16x8*)up;
#pragma unroll
          for (int e = 0; e < 8; ++e) { cur[e] = bf2f((unsigned short)v[e]); acc[e] = cur[e]; } }
        for (int j = 1; j < n; ++j) { const bf16x8 v = *(const bf16x8*)(up - (size_t)j * NPROJ);
#pragma unroll
            for (int e = 0; e < 8; ++e) acc[e] += bf2f((unsigned short)v[e]); }
        const float inv = 1.0f / (float)n;
        v4u o; o.x = pk2(acc[0] * inv - cur[0], acc[1] * inv - cur[1]); o.y = pk2(acc[2] * inv - cur[2], acc[3] * inv - cur[3]);
        o.z = pk2(acc[4] * inv - cur[4], acc[5] * inv - cur[5]); o.w = pk2(acc[6] * inv - cur[6], acc[7] * inv - cur[7]);
        *(v4u*)(F.CAT + (size_t)tok * 1024 + 512 + cgp * 8) = o;
    }
}

__device__ __forceinline__ unsigned cvtpk_rne(float lo, float hi) { unsigned r; asm volatile("v_cvt_pk_bf16_f32 %0, %1, %2" : "=v"(r) : "v"(lo), "v"(hi)); return r; }
__device__ __forceinline__ void glds16(const void* gsrc, unsigned lds_dst) { unsigned keep;
    asm volatile("s_mov_b32 %0, m0\n\ts_mov_b32 m0, %2\n\ts_nop 0\n\tglobal_load_lds_dwordx4 %1, off\n\ts_mov_b32 m0, %0" : "=&s"(keep) : "v"(gsrc), "s"(lds_dst) : "memory"); }
#define ATT_WAIT_BAR(N) asm volatile("s_waitcnt vmcnt(" #N ") lgkmcnt(0)\n\ts_barrier" ::: "memory")
constexpr int ATT_RING = 8704, ATT_SLOT = 16384, ATT_NSLOT = 8, ATT_AHEAD = 4;
__device__ __forceinline__ void attn_wg_item(Frame& F, const LAS float* btab, float shift, int b, int h, int c0) {
    const int lane = F.lane, w = F.wave, r32 = lane & 31, hi = lane >> 5, wq = w >> 1, half = w & 1;
    const int c = c0 + wq, qi = half * 32 + r32, tokq = b * SEQ + c * 64 + qi;
    bf16x8 qf[4];
    { const bf16* qp = F.QKU + (size_t)tokq * NPROJ + h * 64 + hi * 8;
#pragma unroll
      for (int d0 = 0; d0 < 4; ++d0) qf[d0] = *(const bf16x8*)(qp + d0 * 16); }
    const int pi = (r32 & 16) + 8 * ((r32 >> 2) & 1) + (r32 & 3) + 4 * ((r32 >> 3) & 1);
    float l_run = 0.f; f32x16 o0 = {}, o1 = {};
    const int drow = F.tid >> 3, dch = (F.tid & 7) ^ (drow & 7);
    const bf16* kg = F.QKU + (size_t)(b * SEQ + (c0 - 8) * 64 + drow) * NPROJ + 512 + h * 64 + dch * 8;
    const bf16* vg = F.VT + (size_t)(h * 64 + drow) * M + b * SEQ + (c0 - 8) * 64 + dch * 8;
    const unsigned ring0 = (unsigned)(uintptr_t)(F.lds + ATT_RING) + (unsigned)w * 1024u;
    const LAS unsigned char* ring = F.lds + ATT_RING;
    const int kofs = pi * 128, ksw = pi & 7, vofs = 8192 + r32 * 128, vsw = r32 & 7;
    const int jmin = c0 >= 8 ? 0 : 8 - c0, n = 12 - jmin;
#define ATT_DMA(i) do { const int j_ = jmin + (i); const unsigned dst_ = (unsigned)__builtin_amdgcn_readfirstlane(ring0 + (unsigned)((i) & (ATT_NSLOT - 1)) * ATT_SLOT); \
        glds16(kg + (size_t)j_ * 64 * NPROJ, dst_); glds16(vg + j_ * 64, dst_ + 8192u); } while (0)
#pragma unroll
    for (int i = 0; i < ATT_AHEAD; ++i) ATT_DMA(i);
    for (int i = 0; i < n; ++i) {
        const int rem = n - 1 - i;
        if (rem >= 3) ATT_WAIT_BAR(6); else if (rem == 2) ATT_WAIT_BAR(4); else if (rem == 1) ATT_WAIT_BAR(2); else ATT_WAIT_BAR(0);
        if (i + ATT_AHEAD < n) ATT_DMA(i + ATT_AHEAD);
        const int j = jmin + i, t = j - wq;
        if (t >= 0 && t <= 8) {
            const LAS unsigned char* sl = ring + (i & (ATT_NSLOT - 1)) * ATT_SLOT;
            bf16x8 kf0[4], kf1[4], vf[4][2];
#pragma unroll
            for (int d0 = 0; d0 < 4; ++d0) { kf0[d0] = *(const LAS bf16x8*)(sl + kofs + (((2 * d0 + hi) ^ ksw) << 4)); kf1[d0] = *(const LAS bf16x8*)(sl + 4096 + kofs + (((2 * d0 + hi) ^ ksw) << 4)); }
            f32x16 p0, p1;
#pragma unroll
            for (int r = 0; r < 16; ++r) { p0[r] = -shift; p1[r] = -shift; }
#pragma unroll
            for (int d0 = 0; d0 < 4; ++d0) { p0 = __builtin_amdgcn_mfma_f32_32x32x16_bf16(kf0[d0], qf[d0], p0, 0, 0, 0); p1 = __builtin_amdgcn_mfma_f32_32x32x16_bf16(kf1[d0], qf[d0], p1, 0, 0, 0); }
#pragma unroll
            for (int ks = 0; ks < 4; ++ks) { vf[ks][0] = *(const LAS bf16x8*)(sl + vofs + (((2 * ks + hi) ^ vsw) << 4)); vf[ks][1] = *(const LAS bf16x8*)(sl + 4096 + vofs + (((2 * ks + hi) ^ vsw) << 4)); }
            if (t >= 6) {
                const int base_ = 512 - 64 * t + qi - 8 * hi + 128;
#pragma unroll
                for (int r = 0; r < 16; ++r) { const int off_ = 16 * (r >> 3) + (r & 7); int i0 = base_ - off_, i1 = base_ - 32 - off_; i0 = i0 > 256 ? 256 : i0; i1 = i1 > 256 ? 256 : i1;
                    p0[r] += btab[i0]; p1[r] += btab[i1]; }
            }
            float s_ = 0.f;
#pragma unroll
            for (int r = 0; r < 16; ++r) { p0[r] = __builtin_amdgcn_exp2f(p0[r]); p1[r] = __builtin_amdgcn_exp2f(p1[r]); s_ += p0[r] + p1[r]; }
            l_run += s_;
            v4u w0, w1, w2, w3;
            w0.x = cvtpk_rne(p0[0], p0[1]); w0.y = cvtpk_rne(p0[2], p0[3]); w0.z = cvtpk_rne(p0[4], p0[5]); w0.w = cvtpk_rne(p0[6], p0[7]);
            w1.x = cvtpk_rne(p0[8], p0[9]); w1.y = cvtpk_rne(p0[10], p0[11]); w1.z = cvtpk_rne(p0[12], p0[13]); w1.w = cvtpk_rne(p0[14], p0[15]);
            w2.x = cvtpk_rne(p1[0], p1[1]); w2.y = cvtpk_rne(p1[2], p1[3]); w2.z = cvtpk_rne(p1[4], p1[5]); w2.w = cvtpk_rne(p1[6], p1[7]);
            w3.x = cvtpk_rne(p1[8], p1[9]); w3.y = cvtpk_rne(p1[10], p1[11]); w3.z = cvtpk_rne(p1[12], p1[13]); w3.w = cvtpk_rne(p1[14], p1[15]);
            const bf16x8 pw0 = __builtin_bit_cast(bf16x8, w0), pw1 = __builtin_bit_cast(bf16x8, w1), pw2 = __builtin_bit_cast(bf16x8, w2), pw3 = __builtin_bit_cast(bf16x8, w3);
            o0 = __builtin_amdgcn_mfma_f32_32x32x16_bf16(vf[0][0], pw0, o0, 0, 0, 0); o1 = __builtin_amdgcn_mfma_f32_32x32x16_bf16(vf[0][1], pw0, o1, 0, 0, 0);
            o0 = __builtin_amdgcn_mfma_f32_32x32x16_bf16(vf[1][0], pw1, o0, 0, 0, 0); o1 = __builtin_amdgcn_mfma_f32_32x32x16_bf16(vf[1][1], pw1, o1, 0, 0, 0);
            o0 = __builtin_amdgcn_mfma_f32_32x32x16_bf16(vf[2][0], pw2, o0, 0, 0, 0); o1 = __builtin_amdgcn_mfma_f32_32x32x16_bf16(vf[2][1], pw2, o1, 0, 0, 0);
            o0 = __builtin_amdgcn_mfma_f32_32x32x16_bf16(vf[3][0], pw3, o0, 0, 0, 0); o1 = __builtin_amdgcn_mfma_f32_32x32x16_bf16(vf[3][1], pw3, o1, 0, 0, 0);
        }
    }
#undef ATT_DMA
    const float l = l_run + __shfl_xor(l_run, 32), inv = 1.0f / l;
    bf16* op = F.CAT + (size_t)tokq * 1024 + h * 64 + 4 * hi;
#pragma unroll
    for (int g4 = 0; g4 < 4; ++g4) {
        v2u a, bq; a.x = cvtpk_rne(o0[4 * g4] * inv, o0[4 * g4 + 1] * inv); a.y = cvtpk_rne(o0[4 * g4 + 2] * inv, o0[4 * g4 + 3] * inv);
        bq.x = cvtpk_rne(o1[4 * g4] * inv, o1[4 * g4 + 1] * inv); bq.y = cvtpk_rne(o1[4 * g4 + 2] * inv, o1[4 * g4 + 3] * inv);
        *(v2u*)(op + 8 * g4) = a; *(v2u*)(op + 32 + 8 * g4) = bq;
    }
    ATT_WAIT_BAR(0);
}
__device__ __forceinline__ void attn_phase(Frame& F) {
    LAS float* tab = (LAS float*)F.lds;
    float bm = -1e30f;
    for (int i = F.tid; i < NH * NREL; i += NWAVES * 64) { const int h = i / NREL; const float v = (F.relb[i] - F.relb[h * NREL + 256]) * LOG2E; tab[i] = v; bm = fmaxf(bm, v); }
#pragma unroll
    for (int o = 1; o < 64; o <<= 1) bm = fmaxf(bm, __shfl_xor(bm, o));
    if (F.lane == 0) tab[NH * NREL + F.wave] = bm;
    float qm = fabsf(F.qn[F.lane]), km = fabsf(F.kn[F.lane]);
#pragma unroll
    for (int o = 1; o < 64; o <<= 1) { qm = fmaxf(qm, __shfl_xor(qm, o)); km = fmaxf(km, __shfl_xor(km, o)); }
    __syncthreads();
    float bmax = tab[NH * NREL];
#pragma unroll
    for (int i = 1; i < NWAVES; ++i) bmax = fmaxf(bmax, tab[NH * NREL + i]);
    const float bound = 8.0f * qm * km * LOG2E + bmax;
    const float shift = bound > 80.f ? bound - 80.f : 0.f;
    for (int it = F.vcu; it < BATCH * NH * 16; it += F.G) {
        const int rk = it >> 8, v = it & 255, bh = v >> 2, sub = v & 3;
        attn_wg_item(F, tab + (bh & 7) * NREL, shift, bh >> 3, bh & 7, rk * 16 + sub * 4);
    }
    __syncthreads();
}
#undef ATT_WAIT_BAR

__device__ __forceinline__ void final_norm(Frame& F) {
    const int gw = F.vcu * NWAVES + F.wave, NGW = F.G * NWAVES;
    f32x4 g[4];
#pragma unroll
    for (int j = 0; j < 4; ++j) g[j] = *(const f32x4*)(F.nf + (j >> 1) * 512 + 8 * F.lane + 4 * (j & 1));
    for (int m0 = 4 * gw; m0 < M; m0 += 4 * NGW) {
        v4u r[4][2]; float ri[4];
#pragma unroll
        for (int q = 0; q < 4; ++q) { const v4u* xr = (const v4u*)(F.XB + (size_t)(m0 + q) * D); r[q][0] = xr[F.lane]; r[q][1] = xr[64 + F.lane]; ri[q] = pg8::row_rinv(F.SS3, m0 + q); }
#pragma unroll
        for (int q = 0; q < 4; ++q) { float* orow = F.out + (size_t)(m0 + q) * D;
#pragma unroll
            for (int hh = 0; hh < 2; ++hh) { const v4u w = r[q][hh];
                const f32x4 a = (f32x4){__builtin_bit_cast(float, w.x << 16), __builtin_bit_cast(float, w.x & 0xffff0000u), __builtin_bit_cast(float, w.y << 16), __builtin_bit_cast(float, w.y & 0xffff0000u)};
                const f32x4 bq = (f32x4){__builtin_bit_cast(float, w.z << 16), __builtin_bit_cast(float, w.z & 0xffff0000u), __builtin_bit_cast(float, w.w << 16), __builtin_bit_cast(float, w.w & 0xffff0000u)};
                *(f32x4*)(orow + hh * 512 + 8 * F.lane) = a * ri[q] * g[2 * hh]; *(f32x4*)(orow + hh * 512 + 8 * F.lane + 4) = bq * ri[q] * g[2 * hh + 1]; } }
    }
}

struct Args { const float* in[18]; float* out; unsigned char* ws; int ph_lo, ph_hi; };
__global__ void __launch_bounds__(NWAVES * 64, 2) mk_fwd(Args args) {
    extern __shared__ __attribute__((aligned(16))) unsigned char lds[];
    Frame F;
    F.lds = (LAS unsigned char*)lds;
    F.tid = threadIdx.x; F.lane = F.tid & 63; F.wave = __builtin_amdgcn_readfirstlane(F.tid >> 6);
    F.G = gridDim.x; { const int bx = blockIdx.x; F.vcu = (F.G % 8 == 0) ? (bx % 8) * (F.G / 8) + bx / 8 : bx; }
    unsigned char* ws = args.ws;
    F.x = args.in[0]; F.n1 = args.in[1]; F.wg1 = args.in[2]; F.wu1 = args.in[3]; F.wd1 = args.in[4]; F.nm = args.in[5]; F.win = args.in[6]; F.qn = args.in[7]; F.kn = args.in[8];
    F.relb = args.in[9]; F.poolw = args.in[10]; F.pools = args.in[11]; F.wout = args.in[12]; F.n2 = args.in[13]; F.wg2 = args.in[14]; F.wu2 = args.in[15]; F.wd2 = args.in[16]; F.nf = args.in[17];
    F.out = args.out;
    F.SS0 = (float*)(ws + WS_SS0); F.SS1 = (float*)(ws + WS_SS1); F.SS2 = (float*)(ws + WS_SS2); F.SS3 = (float*)(ws + WS_SS3);
    F.Wgu1 = (bf16*)(ws + WS_WGU1); F.Wd1 = (bf16*)(ws + WS_WD1); F.Win = (bf16*)(ws + WS_WIN); F.Wv = (bf16*)(ws + WS_WV); F.Wout = (bf16*)(ws + WS_WOUT); F.Wgu2 = (bf16*)(ws + WS_WGU2); F.Wd2 = (bf16*)(ws + WS_WD2);
    F.XB = (bf16*)(ws + WS_XB); F.H = (bf16*)(ws + WS_H); F.QKU = (bf16*)(ws + WS_QKU); F.VT = (bf16*)(ws + WS_VT); F.CAT = (bf16*)(ws + WS_CAT);
    cg::grid_group grid = cg::this_grid();
    volatile LAS unsigned* bst = (volatile LAS unsigned*)(F.lds + LDS_BYTES - 64);
    if (F.tid < 2) bst[F.tid] = 0u;
    __syncthreads();
    XcdBarrier bar = xcd_barrier_post((unsigned*)ws, bst);
    const int lo = args.ph_lo, hi = args.ph_hi;
#define IN(k) (lo <= (k) && (k) < hi)
#define SEAM(k) do { if (IN(k) && IN((k) + 1)) { if (lo > 1000) grid.sync();   xcd_barrier(bar); } } while (0)
    const int bid = (int)blockIdx.x;

    if (IN(0)) { p0_prologue(F); SEAM(0); }
    if (IN(1)) {
        pg8::Gemm g{F.XB, F.Wgu1, M, 2 * FF, D}; pg8::StaticOrder S; S.init(M, 2 * FF, F.G, bid);
        pg8::EpiSwiGLU E{F.H, FF, F.SS0};
        pg8::gemm_phase<pg8::EpiSwiGLU, pg8::StaticOrder, true, true>(F.lds, g, S, E);
        SEAM(1);
    }
    if (IN(2)) {
        pg8::Gemm g{F.H, F.Wd1, M, D, FF}; pg8::StaticOrder S; S.init(M, D, F.G, bid);
        pg8::EpiRes<false> E{F.x, F.XB, F.SS1, 0.5f};
        pg8::gemm_phase<pg8::EpiRes<false>, pg8::StaticOrder, true, true>(F.lds, g, S, E);
        SEAM(2);
    }
    if (IN(3)) {
        { pg8::Gemm g{F.XB, F.Win, M, NPROJ, D}; pg8::StaticOrder S; S.init(M, NPROJ, F.G, bid);
          pg8::EpiProj E{F.QKU, F.SS1, F.qn, F.kn, 0.125f * LOG2E};
          pg8::gemm_phase<pg8::EpiProj, pg8::StaticOrder, true, true>(F.lds, g, S, E); }
        { pg8::Gemm g{F.Wv, F.XB, 512, M, D}; pg8::StaticOrder S; S.init(512, M, F.G, bid);
          pg8::EpiVT E{F.VT, M, F.SS1};
          pg8::gemm_phase<pg8::EpiVT, pg8::StaticOrder, true, true>(F.lds, g, S, E); }
        SEAM(3);
    }
    if (IN(4)) { pool_phase(F); attn_phase(F); SEAM(4); }
    if (IN(5)) {
        pg8::Gemm g{F.CAT, F.Wout, M, D, D}; pg8::StaticOrder S; S.init(M, D, F.G, bid);
        pg8::EpiRes<true> E{nullptr, F.XB, F.SS2, 1.0f};
        pg8::gemm_phase<pg8::EpiRes<true>, pg8::StaticOrder, true, true>(F.lds, g, S, E);
        SEAM(5);
    }
    if (IN(6)) {
        pg8::Gemm g{F.XB, F.Wgu2, M, 2 * FF, D}; pg8::StaticOrder S; S.init(M, 2 * FF, F.G, bid);
        pg8::EpiSwiGLU E{F.H, FF, F.SS2};
        pg8::gemm_phase<pg8::EpiSwiGLU, pg8::StaticOrder, true, true>(F.lds, g, S, E);
        SEAM(6);
    }
    if (IN(7)) {
        pg8::Gemm g{F.H, F.Wd2, M, D, FF}; pg8::StaticOrder S; S.init(M, D, F.G, bid);
        pg8::EpiRes<true> E{nullptr, F.XB, F.SS3, 0.5f};
        pg8::gemm_phase<pg8::EpiRes<true>, pg8::StaticOrder, true, true>(F.lds, g, S, E);
        SEAM(7);
    }
    if (IN(8)) final_norm(F);
#undef IN
#undef SEAM
}

extern "C" void kernel_launch(void* const* d_in, const int* in_sizes, int n_in, void* d_out, int out_size, void* d_ws, size_t ws_size, hipStream_t stream) {
    static int grid = 0;
    if (grid == 0) {
        if (n_in != 18 || in_sizes[0] != M * D || out_size != M * D || ws_size < WS_END) { fprintf(stderr, "kernel_launch: unexpected shapes (n_in %d, in0 %d, out %d, ws %zu); nothing launched\n", n_in, n_in > 0 ? in_sizes[0] : -1, out_size, ws_size); grid = -1; return; }
        int dev = 0, cus = 0, per_cu = 0;
        if (hipGetDevice(&dev) != hipSuccess || hipDeviceGetAttribute(&cus, hipDeviceAttributeMultiprocessorCount, dev) != hipSuccess) { grid = -1; return; }
        if (hipFuncSetAttribute((const void*)mk_fwd, hipFuncAttributeMaxDynamicSharedMemorySize, LDS_BYTES) != hipSuccess) { fprintf(stderr, "kernel_launch: hipFuncSetAttribute failed\n"); grid = -1; return; }
        if (hipOccupancyMaxActiveBlocksPerMultiprocessor(&per_cu, (const void*)mk_fwd, NWAVES * 64, LDS_BYTES) != hipSuccess || per_cu < 1) { fprintf(stderr, "kernel_launch: occupancy query says %d\n", per_cu); per_cu = 1; }
        (void)hipGetLastError();
        grid = cus * per_cu;
    }
    if (grid < 0) return;
    Args a{};
    for (int i = 0; i < 18; ++i) a.in[i] = (const float*)d_in[i];
    a.out = (float*)d_out; a.ws = (unsigned char*)d_ws;
    if (MK_N_LAUNCHES == 1) {
        if (hipMemsetAsync(d_ws, 0, 16384, stream) != hipSuccess) { fprintf(stderr, "kernel_launch: memset failed\n"); return; }
        a.ph_lo = 0; a.ph_hi = N_PHASES;
        void* kargs[] = {&a};
        const hipError_t e = hipLaunchCooperativeKernel((const void*)mk_fwd, dim3(grid), dim3(NWAVES * 64), kargs, LDS_BYTES, stream);
        if (e != hipSuccess) fprintf(stderr, "kernel_launch: cooperative launch failed: %s (grid %d)\n", hipGetErrorString(e), grid);
    } else {
        for (int p = 0; p < N_PHASES; ++p) { a.ph_lo = p; a.ph_hi = p + 1; hipLaunchKernelGGL(mk_fwd, dim3(grid), dim3(NWAVES * 64), LDS_BYTES, stream, a); }
    }
}
```
